# Optimizing an MI355X kernel written in HIP

```python
import math
import jax, jax.numpy as jnp
from jax import lax
import numpy as np

D_MODEL = 4096
BATCH = 2
SEQ = 8192
DEPTH = 1
DEC_BATCH = 8
DEC_SEQ = 32
PAST_LEN = 1024

CHUNK = 64
N_HEADS = 16
HEAD_DIM = 128
V_DIM = 2 * HEAD_DIM
ATTN_Q = N_HEADS * 2 * HEAD_DIM
ATTN_K = N_HEADS * 2 * HEAD_DIM
ATTN_V = N_HEADS * V_DIM
POOL_WINDOWS = (2, 4, 8, 16)
N_POOL_GROUPS = len(POOL_WINDOWS)
POOL_GROUP_IN = D_MODEL // 8
POOL_IN = N_POOL_GROUPS * POOL_GROUP_IN
POOL_GROUP_OUT = D_MODEL // N_POOL_GROUPS
POOL_HIST = max(POOL_WINDOWS) - 1
D_FF = -(-(8 * D_MODEL) // (3 * 256)) * 256
IN_COLS = POOL_IN + ATTN_Q + ATTN_K + ATTN_V + 2 * D_MODEL
QBLOCK = 128
EPS = 1e-6

kernel_name = 'gated_pool_diffattn_streaming_step'


def rms_norm(x, g):
    xf = x.astype(jnp.float32)
    y = xf * lax.rsqrt(jnp.mean(xf * xf, axis=-1, keepdims=True) + EPS) * g.astype(jnp.float32)
    return y.astype(x.dtype)


def lambda_init(layer):
    return 0.8 - 0.6 * math.exp(-0.3 * layer)


def project(x, norm_g, w_in, q_g, k_g):
    B, T = x.shape[0], x.shape[1]
    h = rms_norm(x, norm_g)
    z = h @ w_in
    o1 = POOL_IN
    o2 = o1 + ATTN_Q
    o3 = o2 + ATTN_K
    o4 = o3 + ATTN_V
    o5 = o4 + D_MODEL
    u = z[..., :o1]
    q = rms_norm(z[..., o1:o2].reshape(B, T, N_HEADS, 2, HEAD_DIM), q_g)
    k = rms_norm(z[..., o2:o3].reshape(B, T, N_HEADS, 2, HEAD_DIM), k_g)
    v = z[..., o3:o4].reshape(B, T, N_HEADS, V_DIM)
    return u, q, k, v, z[..., o4:o5], z[..., o5:]


def pool_mix(u_ext, pos, w_pool, pool_scale):
    B = u_ext.shape[0]
    T = pos.shape[0]
    uf = u_ext.astype(jnp.float32)
    cs = jnp.pad(jnp.cumsum(uf, axis=1), ((0, 0), (1, 0), (0, 0)))
    u_new = uf[:, POOL_HIST:]
    outs = []
    for g, w in enumerate(POOL_WINDOWS):
        c0, c1 = g * POOL_GROUP_IN, (g + 1) * POOL_GROUP_IN
        hi = cs[:, POOL_HIST + 1:POOL_HIST + 1 + T, c0:c1]
        lo = cs[:, POOL_HIST + 1 - w:POOL_HIST + 1 - w + T, c0:c1]
        cnt = jnp.minimum(pos + 1, w).astype(jnp.float32)
        outs.append((hi - lo) / cnt[None, :, None] - u_new[:, :, c0:c1])
    pooled = jnp.stack(outs, axis=2).astype(u_ext.dtype)
    y = jnp.einsum('btgc,gcd->btgd', pooled, w_pool)
    return y.reshape(B, T, D_MODEL) * pool_scale


def diff_attention(q, k, v, q_pos, k_pos, lam):
    s = jnp.einsum('bthmd,bshmd->bhmts', q, k, preferred_element_type=jnp.float32) * (HEAD_DIM ** -0.5)
    mask = (k_pos[None, :] // CHUNK) <= (q_pos[:, None] // CHUNK)
    s = jnp.where(mask, s, jnp.finfo(jnp.float32).min)
    p = jax.nn.softmax(s, axis=-1)
    a = p[:, :, 0] - lam * p[:, :, 1]
    return jnp.einsum('bhts,bshe->bthe', a.astype(v.dtype), v, preferred_element_type=jnp.float32)


def attn_out(o, subln_g, lam_i, dtype):
    B, T = o.shape[0], o.shape[1]
    y = o * lax.rsqrt(jnp.mean(o * o, axis=-1, keepdims=True) + EPS) * subln_g.astype(jnp.float32)
    y = y * (1.0 - lam_i)
    return y.reshape(B, T, ATTN_V).astype(dtype)


def merge(x, pool_y, attn_y, ga, gb, w_out):
    mix = jax.nn.sigmoid(ga) * pool_y + jax.nn.sigmoid(gb) * attn_y
    return x + mix @ w_out


def ffn(x, g, w_in, w_out):
    gu = rms_norm(x, g) @ w_in
    return x + (jax.nn.silu(gu[..., :D_FF]) * gu[..., D_FF:]) @ w_out


def setup_inputs(seed: int = 0) -> dict:
    key = jax.random.key(seed)
    ks = jax.random.split(key, 24)
    f32 = jnp.float32
    nrm = lambda k, shape, scale: jax.random.normal(k, shape, f32) * scale
    gain = lambda k, shape: 1.0 + 0.02 * jax.random.normal(k, shape, f32)
    return {
        'x_prompt': nrm(ks[0], (BATCH, SEQ, D_MODEL), 1.0),
        'x_sample': nrm(ks[1], (DEC_BATCH, DEC_SEQ, D_MODEL), 1.0),
        'cache_pool': nrm(ks[2], (DEPTH, DEC_BATCH, POOL_HIST, POOL_IN), 1.0),
        'cache_k': nrm(ks[3], (DEPTH, DEC_BATCH, PAST_LEN, N_HEADS, 2, HEAD_DIM), 1.0),
        'cache_v': nrm(ks[4], (DEPTH, DEC_BATCH, PAST_LEN, N_HEADS, V_DIM), 1.0),
        'norm_mix': gain(ks[5], (DEPTH, D_MODEL)),
        'w_in': nrm(ks[6], (DEPTH, D_MODEL, IN_COLS), D_MODEL ** -0.5),
        'w_pool': nrm(ks[7], (DEPTH, N_POOL_GROUPS, POOL_GROUP_IN, POOL_GROUP_OUT), POOL_GROUP_IN ** -0.5),
        'pool_scale': gain(ks[8], (DEPTH, D_MODEL)),
        'q_norm': gain(ks[9], (DEPTH, HEAD_DIM)),
        'k_norm': gain(ks[10], (DEPTH, HEAD_DIM)),
        'lambda_q1': nrm(ks[11], (DEPTH, HEAD_DIM), 0.1),
        'lambda_k1': nrm(ks[12], (DEPTH, HEAD_DIM), 0.1),
        'lambda_q2': nrm(ks[13], (DEPTH, HEAD_DIM), 0.1),
        'lambda_k2': nrm(ks[14], (DEPTH, HEAD_DIM), 0.1),
        'subln': gain(ks[15], (DEPTH, V_DIM)),
        'w_out': nrm(ks[16], (DEPTH, D_MODEL, D_MODEL), D_MODEL ** -0.5),
        'norm_ffn': gain(ks[17], (DEPTH, D_MODEL)),
        'w_ffn_in': nrm(ks[18], (DEPTH, D_MODEL, 2 * D_FF), D_MODEL ** -0.5),
        'w_ffn_out': nrm(ks[19], (DEPTH, D_FF, D_MODEL), D_FF ** -0.5),
    }


def reference(x_prompt, x_sample, cache_pool, cache_k, cache_v, norm_mix, w_in, w_pool, pool_scale,
              q_norm, k_norm, lambda_q1, lambda_k1, lambda_q2, lambda_k2, subln, w_out,
              norm_ffn, w_ffn_in, w_ffn_out):
    f32 = jnp.float32
    xp, xs = x_prompt, x_sample
    T_p, T_s = xp.shape[1], xs.shape[1]
    past = cache_k.shape[2]
    pos_p = jnp.arange(T_p)
    pos_s = past + jnp.arange(T_s)
    pos_ks = jnp.arange(past + T_s)
    pool_p, k_p, v_p, pool_s, k_s, v_s = [], [], [], [], [], []
    for l in range(DEPTH):
        lam_i = lambda_init(l)
        lam = (jnp.exp(jnp.sum(lambda_q1[l].astype(f32) * lambda_k1[l].astype(f32)))
               - jnp.exp(jnp.sum(lambda_q2[l].astype(f32) * lambda_k2[l].astype(f32))) + lam_i)

        u, q, k, v, ga, gb = project(xp, norm_mix[l], w_in[l], q_norm[l], k_norm[l])
        u_ext = jnp.concatenate([jnp.zeros((xp.shape[0], POOL_HIST, POOL_IN), u.dtype), u], axis=1)
        pool_y = pool_mix(u_ext, pos_p, w_pool[l], pool_scale[l])
        blocks = []
        for i in range(T_p // QBLOCK):
            e = (i + 1) * QBLOCK
            blocks.append(diff_attention(q[:, e - QBLOCK:e], k[:, :e], v[:, :e],
                                         pos_p[e - QBLOCK:e], pos_p[:e], lam))
        attn_y = attn_out(jnp.concatenate(blocks, axis=1), subln[l], lam_i, xp.dtype)
        xp = merge(xp, pool_y, attn_y, ga, gb, w_out[l])
        xp = ffn(xp, norm_ffn[l], w_ffn_in[l], w_ffn_out[l])
        pool_p.append(u_ext[:, -POOL_HIST:])
        k_p.append(k)
        v_p.append(v)

        u, q, k, v, ga, gb = project(xs, norm_mix[l], w_in[l], q_norm[l], k_norm[l])
        u_ext = jnp.concatenate([cache_pool[l], u], axis=1)
        pool_y = pool_mix(u_ext, pos_s, w_pool[l], pool_scale[l])
        k_all = jnp.concatenate([cache_k[l], k], axis=1)
        v_all = jnp.concatenate([cache_v[l], v], axis=1)
        o = diff_attention(q, k_all, v_all, pos_s, pos_ks, lam)
        attn_y = attn_out(o, subln[l], lam_i, xs.dtype)
        xs = merge(xs, pool_y, attn_y, ga, gb, w_out[l])
        xs = ffn(xs, norm_ffn[l], w_ffn_in[l], w_ffn_out[l])
        pool_s.append(u_ext[:, -POOL_HIST:])
        k_s.append(k)
        v_s.append(v)

    return (xp, xs, jnp.stack(pool_p), jnp.stack(k_p), jnp.stack(v_p),
            jnp.stack(pool_s), jnp.stack(k_s), jnp.stack(v_s))
```

```cpp
#include <hip/hip_runtime.h>
#include <cstdio>
#include <cstdint>
namespace pg8 {
#define PG8_LAS __attribute__((address_space(3)))
typedef unsigned short bf16_t;
typedef short bf16x8 __attribute__((ext_vector_type(8)));
typedef float f32x4 __attribute__((ext_vector_type(4)));
typedef unsigned u32x4 __attribute__((ext_vector_type(4)));
constexpr int BM = 256, BK = 64, HALF = 128, HTB = HALF * BK * 2  , STAGE_BYTES = 8 * HTB, NXCD = 8, WGM = 8;

__host__ __device__ __forceinline__ int lds_byte(int r, int c) { const int st = (r >> 4) * 2 + (c >> 5), rr = r & 15, cc = c & 31, ob = rr * 64 + cc * 2; return st * 1024 + (ob ^ (((ob >> 9) & 1) << 5)); }
__host__ __device__ __forceinline__ void stage_rc(int b, int& R, int& C) { const int st = b / 1024, sb = b % 1024, swz = sb ^ (((sb >> 9) & 1) << 5); R = (st >> 1) * 16 + swz / 64; C = (st & 1) * 32 + (swz % 64) / 2; }
__host__ __device__ __forceinline__ int perm32(int rho) { const int n = rho >> 4, i = rho & 15; return 8 * (i >> 2) + 4 * n + (i & 3); }

struct Unit { int pm, pn; };
struct Gemm { const bf16_t* A; const bf16_t* Bt; int M, N, K; size_t a_gbytes; int npg; };

struct StaticOrder {
    int nM, nN, nwg, G, c;
    __host__ __device__ void init(int M, int N, int G_, int c_) { nM = M / BM; nN = N / BM; nwg = nM * nN; G = G_; c = c_; }
    __host__ __device__ bool next(int i, Unit& u) const {
        const long L = (long)i * G + c; if (L >= nwg) return false;
        int wgid = (int)L; { const int q = nwg / NXCD, r = nwg % NXCD, xcd = wgid % NXCD, off = wgid / NXCD; wgid = (xcd < r ? xcd * (q + 1) : r * (q + 1) + (xcd - r) * q) + off; }
        const int nig = WGM * nN, gid = wgid / nig, fm = gid * WGM, gsz = (nM - fm) < WGM ? (nM - fm) : WGM;
        u.pm = fm + ((wgid % nig) % gsz); u.pn = (wgid % nig) / gsz; return true;
    }
    __device__ __forceinline__ void a_ready(const Unit&) const {}
    __device__ __forceinline__ void done(const Unit&) const {}
};
typedef float f32x2 __attribute__((ext_vector_type(2)));
typedef __bf16 bf16x2_t __attribute__((ext_vector_type(2)));
__device__ __forceinline__ unsigned cvt_pk_bf16(float lo, float hi) { f32x2 v = {lo, hi}; bf16x2_t b = __builtin_convertvector(v, bf16x2_t); return __builtin_bit_cast(unsigned, b); }
__device__ __forceinline__ float bf_lo(unsigned w) { return __uint_as_float(w << 16); }
__device__ __forceinline__ float bf_hi(unsigned w) { return __uint_as_float(w & 0xffff0000u); }
__device__ __forceinline__ float fsigmoid(float x) { return __builtin_amdgcn_rcpf(1.0f + __builtin_amdgcn_exp2f(-1.4426950408889634f * x)); }
__device__ __forceinline__ u32x4 pack8(const f32x4 a, const f32x4 b) { u32x4 w; w.x = cvt_pk_bf16(a[0], a[1]); w.y = cvt_pk_bf16(a[2], a[3]); w.z = cvt_pk_bf16(b[0], b[1]); w.w = cvt_pk_bf16(b[2], b[3]); return w; }

struct EpiInProj {
    static constexpr bool PERM = true, AFTER_DRAIN = false;
    bf16_t *U, *Q, *K, *V, *GA, *GB; float *nv_p, *nv_s;
    __device__ __forceinline__ void operator()(const f32x4 (&acc)[2][2][4][2], const Unit& u, int wr, int wc, int fr, int fq) const {
        const int pn = u.pn; bf16_t* base; int ldc = 4096, ct, type = 0;
        if (pn < 8) { base = U; ldc = 2048; ct = pn; }
        else if (pn < 24) { base = Q; ct = pn - 8; }
        else if (pn < 40) { base = K; ct = pn - 24; }
        else if (pn < 56) { base = V; ct = pn - 40; type = 1; }
        else if (pn < 72) { base = GA; ct = pn - 56; type = 2; }
        else { base = GB; ct = pn - 72; type = 2; }
        const int row0 = u.pm * BM + wr * 64 + fr, col0 = ct * BM + wc * 32 + 8 * fq;
        float* vout = (u.pm < 64) ? nv_p + (size_t)row0 * 4096 : nv_s + (size_t)(row0 - 16384) * 4096;
#pragma unroll
        for (int ai = 0; ai < 2; ++ai)
#pragma unroll
            for (int m = 0; m < 4; ++m) { const size_t roff = (size_t)(ai * HALF + m * 16); bf16_t* rowp = base + ((size_t)row0 + roff) * ldc + col0;
#pragma unroll
                for (int bj = 0; bj < 2; ++bj) { f32x4 v0 = acc[ai][bj][m][0], v1 = acc[ai][bj][m][1];
                    if (type == 1) { float* vp = vout + roff * 4096 + col0 + bj * HALF; *(f32x4*)vp = v0; *(f32x4*)(vp + 4) = v1; }
                    if (type == 2) {
#pragma unroll
                        for (int e = 0; e < 4; ++e) { v0[e] = fsigmoid(v0[e]); v1[e] = fsigmoid(v1[e]); } }
                    *(u32x4*)(rowp + bj * HALF) = pack8(v0, v1); } }
    }
};

struct EpiPool {
    static constexpr bool PERM = true, AFTER_DRAIN = false;
    bf16_t* GA; const float* pscale;
    __device__ __forceinline__ void operator()(const f32x4 (&acc)[2][2][4][2], const Unit& u, int wr, int wc, int fr, int fq) const {
        const int row0 = u.pm * BM + wr * 64 + fr, col0 = u.pn * BM + wc * 32 + 8 * fq;
        f32x4 ps[2][2];
#pragma unroll
        for (int bj = 0; bj < 2; ++bj)
#pragma unroll
            for (int n = 0; n < 2; ++n) ps[bj][n] = *(const f32x4*)(pscale + col0 + bj * HALF + 4 * n);
#pragma unroll
        for (int ai = 0; ai < 2; ++ai)
#pragma unroll
            for (int m = 0; m < 4; ++m) { bf16_t* rowp = GA + (size_t)(row0 + ai * HALF + m * 16) * 4096 + col0;
#pragma unroll
                for (int bj = 0; bj < 2; ++bj) { const u32x4 gw = *(const u32x4*)(rowp + bj * HALF);
                    f32x4 v0 = acc[ai][bj][m][0] * ps[bj][0], v1 = acc[ai][bj][m][1] * ps[bj][1];
                    v0[0] *= bf_lo(gw.x); v0[1] *= bf_hi(gw.x); v0[2] *= bf_lo(gw.y); v0[3] *= bf_hi(gw.y);
                    v1[0] *= bf_lo(gw.z); v1[1] *= bf_hi(gw.z); v1[2] *= bf_lo(gw.w); v1[3] *= bf_hi(gw.w);
                    *(u32x4*)(rowp + bj * HALF) = pack8(v0, v1); } }
    }
};

struct EpiWout {
    static constexpr bool PERM = true, AFTER_DRAIN = false;
    const float *xp, *xs; float* y; bf16_t* X1n; const float* gffn; float* rowss;
    __device__ __forceinline__ void operator()(const f32x4 (&acc)[2][2][4][2], const Unit& u, int wr, int wc, int fr, int fq) const {
        const int row0 = u.pm * BM + wr * 64 + fr, col0 = u.pn * BM + wc * 32 + 8 * fq;
        const float* xb = (u.pm < 64) ? xp + (size_t)row0 * 4096 : xs + (size_t)(row0 - 16384) * 4096;
        f32x4 gf[2][2];
#pragma unroll
        for (int bj = 0; bj < 2; ++bj)
#pragma unroll
            for (int n = 0; n < 2; ++n) gf[bj][n] = *(const f32x4*)(gffn + col0 + bj * HALF + 4 * n);
#pragma unroll
        for (int ai = 0; ai < 2; ++ai)
#pragma unroll
            for (int m = 0; m < 4; ++m) { const size_t roff = (size_t)(ai * HALF + m * 16); float ss = 0.f;
#pragma unroll
                for (int bj = 0; bj < 2; ++bj) { const int c = col0 + bj * HALF;
                    f32x4 a = *(const f32x4*)(xb + roff * 4096 + c), b = *(const f32x4*)(xb + roff * 4096 + c + 4);
                    a += acc[ai][bj][m][0]; b += acc[ai][bj][m][1];
                    float* yp = y + ((size_t)row0 + roff) * 4096 + c; *(f32x4*)yp = a; *(f32x4*)(yp + 4) = b;
                    ss += (a[0] * a[0] + a[1] * a[1]) + (a[2] * a[2] + a[3] * a[3]) + (b[0] * b[0] + b[1] * b[1]) + (b[2] * b[2] + b[3] * b[3]);
                    *(u32x4*)(X1n + ((size_t)row0 + roff) * 4096 + c) = pack8(a * gf[bj][0], b * gf[bj][1]); }
                ss += __shfl_xor(ss, 16); ss += __shfl_xor(ss, 32);
                if (fq == 0) (void)__hip_atomic_fetch_add(rowss + row0 + (int)roff, ss, __ATOMIC_RELAXED, __HIP_MEMORY_SCOPE_AGENT);
                if (m & 1) asm volatile("" ::: "memory"); }
    }
};

struct EpiSwiGLU {
    static constexpr bool PERM = true, AFTER_DRAIN = false;
    bf16_t* Hff; const float* rowss;
    __device__ __forceinline__ void operator()(const f32x4 (&acc)[2][2][4][2], const Unit& u, int wr, int wc, int fr, int fq) const {
        const int row0 = u.pm * BM + wr * 64 + fr, col0 = u.pn * HALF + wc * 32 + 8 * fq;
#pragma unroll
        for (int ai = 0; ai < 2; ++ai)
#pragma unroll
            for (int m = 0; m < 4; ++m) { const int r = row0 + ai * HALF + m * 16;
                const float ssq = __hip_atomic_load(rowss + r, __ATOMIC_RELAXED, __HIP_MEMORY_SCOPE_AGENT);
                const float rs = __builtin_amdgcn_rsqf(ssq * (1.0f / 4096.0f) + 1e-6f);
                f32x4 g0 = acc[ai][0][m][0] * rs, g1 = acc[ai][0][m][1] * rs, u0 = acc[ai][1][m][0] * rs, u1 = acc[ai][1][m][1] * rs;
#pragma unroll
                for (int e = 0; e < 4; ++e) { g0[e] = g0[e] * fsigmoid(g0[e]) * u0[e]; g1[e] = g1[e] * fsigmoid(g1[e]) * u1[e]; }
                *(u32x4*)(Hff + (size_t)r * 11008 + col0) = pack8(g0, g1); }
    }
};

struct EpiFfnOut {
    static constexpr bool PERM = true, AFTER_DRAIN = false;
    float* y;
    __device__ __forceinline__ void operator()(const f32x4 (&acc)[2][2][4][2], const Unit& u, int wr, int wc, int fr, int fq) const {
        const int row0 = u.pm * BM + wr * 64 + fr, col0 = u.pn * BM + wc * 32 + 8 * fq;
#pragma unroll
        for (int ai = 0; ai < 2; ++ai)
#pragma unroll
            for (int m = 0; m < 4; ++m) { float* rp = y + (size_t)(row0 + ai * HALF + m * 16) * 4096 + col0;
#pragma unroll
                for (int bj = 0; bj < 2; ++bj) { f32x4 a = *(const f32x4*)(rp + bj * HALF), b = *(const f32x4*)(rp + bj * HALF + 4);
                    a += acc[ai][bj][m][0]; b += acc[ai][bj][m][1]; *(f32x4*)(rp + bj * HALF) = a; *(f32x4*)(rp + bj * HALF + 4) = b; }
                if (m & 1) asm volatile("" ::: "memory"); }
    }
};

template <class Epi, class Sched, bool ALIGN_EPI = false, bool SP2 = false>
__device__ __forceinline__ void gemm_phase(PG8_LAS unsigned char* lds, const Gemm g, const Sched& S, const Epi& E) {
    const int tid = threadIdx.x, wid = __builtin_amdgcn_readfirstlane(tid >> 6), lane = tid & 63, wr = wid >> 2, wc = wid & 3, fr = lane & 15, fq = lane >> 4;
    const int K = g.K, nt = K / BK;
    unsigned voffA[2], voffB[2];
#pragma unroll
    for (int i = 0; i < 2; ++i) { int R, C; stage_rc(tid * 16 + i * 8192, R, C); const int Rb = Epi::PERM ? ((R & ~31) + perm32(R & 31)) : R;
        voffA[i] = (unsigned)(R * K + C) * 2u; voffB[i] = (unsigned)(Rb * K + C) * 2u; }
    const size_t kstep = (size_t)(BK * 2);
    const size_t hstep = (size_t)HALF * K * 2;
    const size_t tstep = 2 * hstep;
    const unsigned ldsw = (unsigned)wid * 1024u;
    const int aoff = lds_byte(wr * 64 + fr, fq * 8), boff = lds_byte(wc * 32 + fr, fq * 8);
#define PG8_SA(b, h) (((b) * 2 + (h)) * HTB)
#define PG8_SB(b, h) ((4 + (b) * 2 + (h)) * HTB)
#define PG8_STAGE(bufoff, gbase, voff) do { _Pragma("unroll") for (int _i = 0; _i < 2; ++_i) \
        __builtin_amdgcn_global_load_lds((const unsigned*)((const char*)(gbase) + (voff)[_i]), (PG8_LAS unsigned*)(lds + (bufoff) + ldsw + _i * 8192), 16, 0, 0); } while (0)
#define PG8_LDA(dst, b, h) do { _Pragma("unroll") for (int m = 0; m < 4; ++m) _Pragma("unroll") for (int k = 0; k < 2; ++k) dst[m][k] = *(const PG8_LAS bf16x8*)(lds + PG8_SA(b, h) + aoff + m * 2048 + k * 1024); } while (0)
#define PG8_LDB(dst, b, h) do { _Pragma("unroll") for (int n = 0; n < 2; ++n) _Pragma("unroll") for (int k = 0; k < 2; ++k) dst[n][k] = *(const PG8_LAS bf16x8*)(lds + PG8_SB(b, h) + boff + n * 2048 + k * 1024); } while (0)
#define PG8_MMA(ai, bj, At, Bt) do { __builtin_amdgcn_s_setprio(1); _Pragma("unroll") for (int m = 0; m < 4; ++m) _Pragma("unroll") for (int n = 0; n < 2; ++n) _Pragma("unroll") for (int k = 0; k < 2; ++k) \
        acc[ai][bj][m][n] = __builtin_amdgcn_mfma_f32_16x16x32_bf16(Bt[n][k], At[m][k], acc[ai][bj][m][n], 0, 0, 0); __builtin_amdgcn_s_setprio(0); } while (0)
#define PG8_WAIT_V(n) asm volatile("s_waitcnt vmcnt(" #n ")" ::: "memory")
#define PG8_WAIT_L(n) asm volatile("s_waitcnt lgkmcnt(" #n ")" ::: "memory")
#define PG8_BAR __builtin_amdgcn_s_barrier()
#define PG8_SCHED __builtin_amdgcn_sched_barrier(0)
    Unit cur, nxt; int ui = 0;
    if (!S.next(0, cur)) return;
    f32x4 acc[2][2][4][2];
#pragma unroll
    for (int a = 0; a < 2; ++a)
#pragma unroll
        for (int b = 0; b < 2; ++b)
#pragma unroll
            for (int m = 0; m < 4; ++m)
#pragma unroll
                for (int n = 0; n < 2; ++n) acc[a][b][m][n] = (f32x4){0.f, 0.f, 0.f, 0.f};
    bf16x8 At[4][2], B0[2][2], B1[2][2];
    const char* cA = (const char*)g.A + (size_t)cur.pm * tstep + (g.npg ? (size_t)(cur.pn / g.npg) * g.a_gbytes : (size_t)0); const char* cB = (const char*)g.Bt + (size_t)cur.pn * tstep;
    S.a_ready(cur);
    if constexpr (SP2) {
        PG8_STAGE(PG8_SB(0, 0), cB, voffB); PG8_STAGE(PG8_SB(0, 1), cB + hstep, voffB); PG8_STAGE(PG8_SA(0, 0), cA, voffA); PG8_STAGE(PG8_SA(0, 1), cA + hstep, voffA);
        if (wr == 1) PG8_BAR;
        PG8_WAIT_V(2); PG8_BAR;
        PG8_STAGE(PG8_SB(1, 0), cB + kstep, voffB); PG8_STAGE(PG8_SA(1, 0), cA + kstep, voffA); PG8_STAGE(PG8_SB(1, 1), cB + hstep + kstep, voffB);
        PG8_WAIT_V(6); PG8_BAR;
    } else {
        PG8_STAGE(PG8_SB(0, 0), cB, voffB); PG8_STAGE(PG8_SA(0, 0), cA, voffA); PG8_STAGE(PG8_SB(0, 1), cB + hstep, voffB); PG8_STAGE(PG8_SA(0, 1), cA + hstep, voffA);
        if (wr == 1) PG8_BAR;
        PG8_WAIT_V(4); PG8_BAR;
        PG8_STAGE(PG8_SB(1, 0), cB + kstep, voffB); PG8_STAGE(PG8_SA(1, 0), cA + kstep, voffA); PG8_STAGE(PG8_SB(1, 1), cB + hstep + kstep, voffB);
        PG8_WAIT_V(6); PG8_BAR;
    }
    for (;;) {
        const bool has_next = S.next(ui + 1, nxt);
        const char* nA = has_next ? (const char*)g.A + (size_t)nxt.pm * tstep + (g.npg ? (size_t)(nxt.pn / g.npg) * g.a_gbytes : (size_t)0) : cA; const char* nB = has_next ? (const char*)g.Bt + (size_t)nxt.pn * tstep : cB;
        for (int t = 0; t < nt; t += 2) {
            const bool last = (t == nt - 2);
            const char* a1 = cA + (size_t)(t + 1) * kstep;
            const char* a2 = last ? nA : cA + (size_t)(t + 2) * kstep; const char* b2 = last ? nB : cB + (size_t)(t + 2) * kstep;
            const char* a3 = a2 + kstep; const char* b3 = b2 + kstep;
            if (last && has_next) S.a_ready(nxt);
            if constexpr (SP2) {
            PG8_LDB(B0, 0, 0); PG8_LDB(B1, 0, 1); PG8_SCHED; PG8_LDA(At, 0, 0); PG8_STAGE(PG8_SA(1, 1), a1 + hstep, voffA);
            PG8_WAIT_V(8); PG8_WAIT_L(0); PG8_BAR; PG8_MMA(0, 0, At, B0); PG8_MMA(0, 1, At, B1); PG8_BAR; PG8_SCHED;
            PG8_LDA(At, 0, 1); PG8_STAGE(PG8_SB(0, 0), b2, voffB); PG8_STAGE(PG8_SB(0, 1), b2 + hstep, voffB); PG8_STAGE(PG8_SA(0, 0), a2, voffA);
            PG8_WAIT_V(8); PG8_WAIT_L(0); PG8_BAR; PG8_MMA(1, 0, At, B0); PG8_MMA(1, 1, At, B1); PG8_BAR; PG8_SCHED;
            PG8_LDB(B0, 1, 0); PG8_LDB(B1, 1, 1); PG8_SCHED; PG8_LDA(At, 1, 0); PG8_STAGE(PG8_SA(0, 1), a2 + hstep, voffA);
            PG8_WAIT_V(8); PG8_WAIT_L(0); PG8_BAR; PG8_MMA(0, 0, At, B0); PG8_MMA(0, 1, At, B1); PG8_BAR; PG8_SCHED;
            PG8_LDA(At, 1, 1); PG8_STAGE(PG8_SB(1, 0), b3, voffB); PG8_STAGE(PG8_SB(1, 1), b3 + hstep, voffB); PG8_STAGE(PG8_SA(1, 0), a3, voffA);
            PG8_WAIT_V(8); PG8_WAIT_L(0); PG8_BAR; PG8_MMA(1, 0, At, B0); PG8_MMA(1, 1, At, B1); PG8_BAR; PG8_SCHED;
            } else {
            PG8_LDB(B0, 0, 0); PG8_SCHED; PG8_LDA(At, 0, 0); PG8_STAGE(PG8_SA(1, 1), a1 + hstep, voffA);
            PG8_WAIT_L(8); PG8_BAR; PG8_WAIT_L(0); PG8_MMA(0, 0, At, B0); PG8_BAR; PG8_SCHED;
            PG8_LDB(B1, 0, 1); PG8_STAGE(PG8_SB(0, 0), b2, voffB);
            PG8_BAR; PG8_WAIT_L(0); PG8_MMA(0, 1, At, B1); PG8_BAR;
            PG8_LDA(At, 0, 1); PG8_STAGE(PG8_SA(0, 0), a2, voffA);
            PG8_BAR; PG8_WAIT_L(0); PG8_MMA(1, 0, At, B0); PG8_BAR; PG8_SCHED;
            PG8_STAGE(PG8_SB(0, 1), b2 + hstep, voffB);
            PG8_WAIT_V(6); PG8_BAR; PG8_MMA(1, 1, At, B1); PG8_BAR;
            PG8_LDB(B0, 1, 0); PG8_SCHED; PG8_LDA(At, 1, 0); PG8_STAGE(PG8_SA(0, 1), a2 + hstep, voffA);
            PG8_WAIT_L(8); PG8_BAR; PG8_WAIT_L(0); PG8_MMA(0, 0, At, B0); PG8_BAR; PG8_SCHED;
            PG8_LDB(B1, 1, 1); PG8_STAGE(PG8_SB(1, 0), b3, voffB);
            PG8_BAR; PG8_WAIT_L(0); PG8_MMA(0, 1, At, B1); PG8_BAR;
            PG8_LDA(At, 1, 1); PG8_STAGE(PG8_SA(1, 0), a3, voffA);
            PG8_BAR; PG8_WAIT_L(0); PG8_MMA(1, 0, At, B0); PG8_BAR; PG8_SCHED;
            PG8_STAGE(PG8_SB(1, 1), b3 + hstep, voffB);
            PG8_WAIT_V(6); PG8_BAR; PG8_MMA(1, 1, At, B1); PG8_BAR;
            }
        }
        if constexpr (ALIGN_EPI) { if (wr == 0) PG8_BAR; }
        if constexpr (!Epi::AFTER_DRAIN) { E(acc, cur, wr, wc, fr, fq); S.done(cur); }
        if (!has_next) break;
#pragma unroll
        for (int a = 0; a < 2; ++a)
#pragma unroll
            for (int b = 0; b < 2; ++b)
#pragma unroll
                for (int m = 0; m < 4; ++m)
#pragma unroll
                    for (int n = 0; n < 2; ++n) acc[a][b][m][n] = (f32x4){0.f, 0.f, 0.f, 0.f};
        cur = nxt; cA = nA; cB = nB; ++ui;
        if constexpr (ALIGN_EPI) { if (wr == 1) PG8_BAR; }
    }
    PG8_WAIT_V(0);
    if constexpr (!ALIGN_EPI) { if (wr == 0) PG8_BAR; }
    PG8_BAR;
    if constexpr (Epi::AFTER_DRAIN) { E.fused(acc, cur, wr, wc, fr, fq, lds, wid, lane); S.done(cur); }
#undef PG8_SA
#undef PG8_SB
#undef PG8_STAGE
#undef PG8_LDA
#undef PG8_LDB
#undef PG8_MMA
#undef PG8_WAIT_V
#undef PG8_WAIT_L
#undef PG8_BAR
#undef PG8_SCHED
}
}
namespace da {
using pg8::bf16_t;
typedef short bf16x8 __attribute__((ext_vector_type(8)));
typedef short s16x4 __attribute__((ext_vector_type(4)));
typedef float f32x16 __attribute__((ext_vector_type(16)));
typedef unsigned u32x4 __attribute__((ext_vector_type(4)));
#define DA_LAS __attribute__((address_space(3)))
#define DA_SBAR() __builtin_amdgcn_sched_barrier(0)
constexpr int PITCH = 4096;
constexpr int ST_BYTES = 65536;
constexpr int OFF_V = 32768;
constexpr int LDS_SCR = 131072;
constexpr int LDS_NEED = LDS_SCR + 8 * 256;

__device__ __forceinline__ int crow(int r, int hi) { return (r & 3) + 8 * (r >> 2) + 4 * hi; }
__device__ __forceinline__ void glds16(const void* gsrc, unsigned lds_dst) { unsigned keep;
    asm volatile("s_mov_b32 %0, m0\n\ts_mov_b32 m0, %2\n\ts_nop 0\n\tglobal_load_lds_dwordx4 %1, off\n\ts_mov_b32 m0, %0" : "=&s"(keep) : "v"(gsrc), "s"(lds_dst) : "memory"); }
__device__ __forceinline__ int swap23(int k) { return (k & ~0xC) | ((k & 4) << 1) | ((k & 8) >> 1); }
__device__ __forceinline__ int v_rd_base(int lane) { return ((lane & 3) << 3) | (((lane >> 2) & 3) << 6) | (((lane >> 4) & 1) << 5) | (((lane >> 5) & 1) << 8); }
constexpr int v_rd_off(int d0, int ks, int half) { return (d0 >> 2) * 16384 + (d0 & 3) * 512 + ks * 4096 + half * 2048; }
template <int OFF> __device__ __forceinline__ s16x4 tr_read(int vb) { s16x4 r; asm volatile("ds_read_b64_tr_b16 %0, %1 offset:%2" : "=&v"(r) : "v"(vb), "i"(OFF) : "memory"); return r; }
template <int D0> __device__ __forceinline__ void pv_one(f32x16& od, int vb, bf16x8 pa0, bf16x8 pa1, bf16x8 pa2, bf16x8 pa3) {
    const s16x4 l0 = tr_read<v_rd_off(D0, 0, 0)>(vb), h0 = tr_read<v_rd_off(D0, 0, 1)>(vb), l1 = tr_read<v_rd_off(D0, 1, 0)>(vb), h1 = tr_read<v_rd_off(D0, 1, 1)>(vb);
    const s16x4 l2 = tr_read<v_rd_off(D0, 2, 0)>(vb), h2 = tr_read<v_rd_off(D0, 2, 1)>(vb), l3 = tr_read<v_rd_off(D0, 3, 0)>(vb), h3 = tr_read<v_rd_off(D0, 3, 1)>(vb);
    asm volatile("s_waitcnt lgkmcnt(0)" ::: "memory"); DA_SBAR();
#define DA_PK(L, H) (bf16x8){L[0], L[1], L[2], L[3], H[0], H[1], H[2], H[3]}
    od = __builtin_amdgcn_mfma_f32_32x32x16_bf16(pa0, DA_PK(l0, h0), od, 0, 0, 0);
    od = __builtin_amdgcn_mfma_f32_32x32x16_bf16(pa1, DA_PK(l1, h1), od, 0, 0, 0);
    od = __builtin_amdgcn_mfma_f32_32x32x16_bf16(pa2, DA_PK(l2, h2), od, 0, 0, 0);
    od = __builtin_amdgcn_mfma_f32_32x32x16_bf16(pa3, DA_PK(l3, h3), od, 0, 0, 0);
#undef DA_PK
}

struct Unit {
    const bf16_t* Q; bf16_t* O;
    const bf16_t* K; const bf16_t* V;
    int nt, nt_lo, nt_hi;
    int sample;
};

__device__ __forceinline__ void attn_unit(const Unit& u, DA_LAS unsigned char* lds, float lam, float Mshift) {
    const int tid = threadIdx.x, lane = tid & 63, r32 = lane & 31, hi = lane >> 5; const int wid = __builtin_amdgcn_readfirstlane(tid >> 6);
    const int g = wid & 3, mp = wid >> 2;
    int my_nt = (g < 2) ? u.nt_lo : u.nt_hi; if (u.sample && g != 0) my_nt = 0;
    const unsigned lds0 = (unsigned)(size_t)lds;
    const bf16_t* src = (wid < 4) ? u.K : u.V;
    unsigned loff[2];
    if (wid < 4) {
#pragma unroll
        for (int p = 0; p < 2; ++p) { const int rl = lane >> 4, c = (lane & 15) ^ ((4 * p + rl) & 7); loff[p] = (unsigned)(rl * PITCH + c * 8); }
    } else { const int kl = (lane & 31) >> 2, lk = (kl & 3) + ((kl & 4) << 1); loff[0] = loff[1] = (unsigned)(lk * PITCH + (lane >> 5) * 32 + (lane & 3) * 8); }
#define DA_UOFF(i) ((wid < 4) ? (unsigned)((4 * ((wid * 8 + (i)) & 15)) * PITCH + (wid >> 1) * 128) \
                              : (unsigned)(((((4 * ((wid - 4) & 1) + ((i) >> 1)) * 8) & ~8) + ((((4 * ((wid - 4) & 1) + ((i) >> 1)) * 8) & 8) >> 1)) * PITCH + ((wid - 4) >> 1) * 128 + ((i) & 1) * 64))
#define DA_DMA(t, stg) do { const bf16_t* sp_ = src + (size_t)(t) * 64 * PITCH; const unsigned ld_ = lds0 + (unsigned)(stg) * ST_BYTES + (unsigned)wid * 8192u; \
        _Pragma("unroll") for (int i_ = 0; i_ < 8; ++i_) glds16(sp_ + (size_t)__builtin_amdgcn_readfirstlane(DA_UOFF(i_)) + loff[i_ & 1], (unsigned)__builtin_amdgcn_readfirstlane(ld_ + i_ * 1024)); } while (0)
    DA_DMA(0, 0);
    bf16x8 qr[8];
    { const bf16_t* Qw = u.Q + (size_t)((my_nt > 0 ? g * 32 : 0) + r32) * PITCH + mp * 128 + hi * 8;
#pragma unroll
      for (int d0 = 0; d0 < 8; ++d0) qr[d0] = *(const bf16x8*)(Qw + d0 * 16); }
    f32x16 o[8];
#pragma unroll
    for (int d0 = 0; d0 < 8; ++d0) o[d0] = f32x16{};
    float l_reg = 0.f;
    const int kro = r32 * 256, kx = (r32 & 7) << 4;
    const int vb0 = (int)lds0 + OFF_V + v_rd_base(lane);
    for (int t = 0; t < u.nt; ++t) {
        asm volatile("s_waitcnt vmcnt(0) lgkmcnt(0)\n\ts_barrier" ::: "memory");
        if (t + 1 < u.nt) DA_DMA(t + 1, (t + 1) & 1);
        if (t < my_nt) {
            const int sb = (t & 1) * ST_BYTES;
            const DA_LAS unsigned char* kb = lds + sb + mp * 16384;
            f32x16 p0 = f32x16{}, p1 = f32x16{};
#pragma unroll
            for (int d0 = 0; d0 < 8; ++d0) { const int cb = (d0 * 32 + hi * 16) ^ kx;
                const bf16x8 b0 = *(const DA_LAS bf16x8*)(kb + kro + cb);
                const bf16x8 b1 = *(const DA_LAS bf16x8*)(kb + 8192 + kro + cb);
                p0 = __builtin_amdgcn_mfma_f32_32x32x16_bf16(b0, qr[d0], p0, 0, 0, 0);
                p1 = __builtin_amdgcn_mfma_f32_32x32x16_bf16(b1, qr[d0], p1, 0, 0, 0); }
#pragma unroll
            for (int r = 0; r < 16; ++r) { p0[r] = __builtin_amdgcn_exp2f(p0[r] - Mshift); p1[r] = __builtin_amdgcn_exp2f(p1[r] - Mshift); }
            if (u.sample && t == u.nt - 1) p1 = f32x16{};
            float ps = 0.f;
#pragma unroll
            for (int r = 0; r < 16; ++r) ps += p0[r] + p1[r];
            l_reg += ps;
            bf16x8 pa0, pa1, pa2, pa3;
#define DA_PK4(P, BASE, OUT) do { unsigned a0 = pg8::cvt_pk_bf16(P[BASE + 0], P[BASE + 1]), a1 = pg8::cvt_pk_bf16(P[BASE + 2], P[BASE + 3]);   \
        unsigned b0_ = pg8::cvt_pk_bf16(P[BASE + 4], P[BASE + 5]), b1_ = pg8::cvt_pk_bf16(P[BASE + 6], P[BASE + 7]);                              \
        auto r0 = __builtin_amdgcn_permlane32_swap(a0, b0_, false, false); auto r1 = __builtin_amdgcn_permlane32_swap(a1, b1_, false, false); \
        u32x4 w = {r0[0], r1[0], r0[1], r1[1]}; OUT = __builtin_bit_cast(bf16x8, w); } while (0)
            DA_PK4(p0, 0, pa0); DA_PK4(p0, 8, pa1); DA_PK4(p1, 0, pa2); DA_PK4(p1, 8, pa3);
#undef DA_PK4
            const int vb = vb0 + sb;
            pv_one<0>(o[0], vb, pa0, pa1, pa2, pa3); pv_one<1>(o[1], vb, pa0, pa1, pa2, pa3); pv_one<2>(o[2], vb, pa0, pa1, pa2, pa3); pv_one<3>(o[3], vb, pa0, pa1, pa2, pa3);
            pv_one<4>(o[4], vb, pa0, pa1, pa2, pa3); pv_one<5>(o[5], vb, pa0, pa1, pa2, pa3); pv_one<6>(o[6], vb, pa0, pa1, pa2, pa3); pv_one<7>(o[7], vb, pa0, pa1, pa2, pa3);
        }
    }
#undef DA_DMA
#undef DA_UOFF
    { auto rr = __builtin_amdgcn_permlane32_swap(__float_as_uint(l_reg), __float_as_uint(l_reg), false, false); l_reg = __uint_as_float(rr[0]) + __uint_as_float(rr[1]); }
    DA_LAS float* wsf = (DA_LAS float*)(lds + LDS_SCR + wid * 256);
    if (hi == 0) wsf[r32] = l_reg;
    asm volatile("s_waitcnt lgkmcnt(0)" ::: "memory");
    float rli[16];
    const float sc = (mp == 1) ? lam : 1.0f;
#pragma unroll
    for (int r = 0; r < 16; ++r) rli[r] = sc * __builtin_amdgcn_rcpf(wsf[crow(r, hi)]);
    asm volatile("s_waitcnt vmcnt(0) lgkmcnt(0)\n\ts_barrier" ::: "memory");
    DA_LAS float* Xg = (DA_LAS float*)lds + g * 8192 + lane;
    if (mp == 1 && my_nt > 0) {
#pragma unroll
        for (int d0 = 0; d0 < 8; ++d0)
#pragma unroll
            for (int r = 0; r < 16; ++r) Xg[(d0 * 16 + r) * 64] = o[d0][r] * rli[r];
    }
    asm volatile("s_waitcnt lgkmcnt(0)\n\ts_barrier" ::: "memory");
    if (mp == 0 && my_nt > 0) {
#pragma unroll
        for (int d0 = 0; d0 < 8; ++d0)
#pragma unroll
            for (int r = 0; r < 16; ++r) o[d0][r] = o[d0][r] * rli[r] - Xg[(d0 * 16 + r) * 64];
        asm volatile("s_waitcnt lgkmcnt(0)" ::: "memory");
        DA_LAS bf16_t* stg = (DA_LAS bf16_t*)(lds + g * 32768);
        DA_LAS bf16_t* sw = stg + (4 * hi) * 264 + r32;
#pragma unroll
        for (int d0 = 0; d0 < 8; ++d0)
#pragma unroll
            for (int r = 0; r < 16; ++r) sw[((r & 3) + 8 * (r >> 2)) * 264 + d0 * 32] = (bf16_t)(pg8::cvt_pk_bf16(o[d0][r], o[d0][r]) & 0xffffu);
        asm volatile("s_waitcnt lgkmcnt(0)" ::: "memory");
        bf16_t* Ow = u.O + (size_t)(g * 32 + (lane >> 5)) * PITCH + (lane & 31) * 8;
        const DA_LAS unsigned char* sr = (const DA_LAS unsigned char*)stg + (lane >> 5) * 528 + (lane & 31) * 16;
#pragma unroll
        for (int i = 0; i < 16; ++i) { const u32x4 w = *(const DA_LAS u32x4*)(sr + i * 2 * 528); *(u32x4*)(Ow + (size_t)i * 2 * PITCH) = w; }
    }
    asm volatile("s_waitcnt lgkmcnt(0)\n\ts_barrier" ::: "memory");
}
}

constexpr int NWAVES = 8;
#ifndef MK_N_LAUNCHES
#define MK_N_LAUNCHES 8
#endif
constexpr int N_LAUNCHES = MK_N_LAUNCHES;
constexpr int N_PHASES = 8;
static_assert(N_LAUNCHES == 1 || N_LAUNCHES == N_PHASES, "MK_N_LAUNCHES is 1 or 8");

constexpr int DM = 4096, SEQ = 8192, MP = 2 * SEQ, DEC_B = 8, DEC_T = 32, MS = DEC_B * DEC_T, M = MP + MS, PAST = 1024, SKROWS = 1088;
constexpr int POOL_IN = 2048, PG_IN = 512, PG_OUT = 1024, DFF = 11008, IN_COLS = 22528;
constexpr float EPS = 1e-6f;
constexpr float QSCALE = 0.08838834764831845f * 1.4426950408889634f;
constexpr float MBOUND = 11.313708498984761f * 1.4426950408889634f;
constexpr size_t OFF_Y = 0, OFF_NPP = 68157440, OFF_NKP = 68218880, OFF_NVP = 135327744, OFF_NPS = 202436608, OFF_NKS = 202682368, OFF_NVS = 203730944, OUT_SIZE = 204779520;

constexpr size_t MiB = 1u << 20;
constexpr size_t WS_CTL = 0, CTL_ZERO_BYTES = 1 * MiB;
constexpr size_t WS_WIN = 2 * MiB;
constexpr size_t WS_H = 178 * MiB;
constexpr size_t WS_SK = 308 * MiB, WS_SV = 376 * MiB;
constexpr size_t WS_WPOOL = 444 * MiB;
constexpr size_t WS_WOUT = 448 * MiB;
constexpr size_t WS_WFO = 480 * MiB;
constexpr size_t WS_POOLED = 566 * MiB;
constexpr size_t WS_U = 631 * MiB;
constexpr size_t WS_Q = 696 * MiB, WS_K = 826 * MiB, WS_V = 956 * MiB, WS_GA = 1086 * MiB, WS_GB = 1216 * MiB;
constexpr size_t WS_HFF = WS_Q;
constexpr size_t WS_END = 1346 * MiB;
static_assert(WS_HFF + (size_t)M * DFF * 2 <= WS_GA, "Hff overlay");
constexpr int CW_TMO = 0, CW_CODE = 1;
constexpr int CW_BAR = 4096;
constexpr int CW_ROWSS = 16384;
static_assert((CW_ROWSS + M) * 4 <= (int)CTL_ZERO_BYTES, "CTL words inside the memset region");

constexpr int RING_OFF = 0, RING_BYTES = 131072;
constexpr int ATT_SCR_OFF = RING_BYTES;
constexpr int LDSCTL_OFF = RING_BYTES + 2048, MISC_OFF = LDSCTL_OFF + 320;
constexpr int LDS_BYTES = 147456;
static_assert(MISC_OFF + 128 <= LDS_BYTES && da::LDS_NEED <= LDSCTL_OFF, "LDS map");

#define GAS __attribute__((address_space(1)))
#define LAS __attribute__((address_space(3)))
typedef unsigned short bf16;
typedef unsigned v4u __attribute__((ext_vector_type(4)));
typedef float f32x4 __attribute__((ext_vector_type(4)));
typedef short bf16x8 __attribute__((ext_vector_type(8)));
typedef GAS unsigned gu32;
typedef GAS unsigned long long gu64;
#define RLX_AGENT __ATOMIC_RELAXED, __HIP_MEMORY_SCOPE_AGENT
#define LDS_WAIT() asm volatile("s_waitcnt lgkmcnt(0)" ::: "memory")
#define VM_WAIT() asm volatile("s_waitcnt vmcnt(0)" ::: "memory")
__device__ __forceinline__ unsigned long long rt() { return __builtin_amdgcn_s_memrealtime(); }
__device__ __forceinline__ unsigned f2bf(float f) { unsigned u = __builtin_bit_cast(unsigned, f); return (u + 0x7fffu + ((u >> 16) & 1u)) >> 16; }
__device__ __forceinline__ unsigned pk2(float lo, float hi) { return f2bf(lo) | (f2bf(hi) << 16); }

#define XB_TMO      128
#define XB_XCNT(j)  (256  + 64 * (j))
#define XB_XSUB(j)  (1280 + 64 * (j))
#define XB_XGEN(j)  (2304 + 64 * (j))
#define XB_TOP      3328
#define XB_TOPGEN   3392
#define XCD_BAR_WORDS 3456
#define XB_SPIN_CAP (1u << 18)

__device__ __forceinline__ unsigned xb_ld(unsigned* p)              { return __hip_atomic_load(p, __ATOMIC_RELAXED, __HIP_MEMORY_SCOPE_AGENT); }
__device__ __forceinline__ unsigned xb_add(unsigned* p, unsigned v) { return __hip_atomic_fetch_add(p, v, __ATOMIC_RELAXED, __HIP_MEMORY_SCOPE_AGENT); }
__device__ __forceinline__ unsigned xb_xcc_id() { return (unsigned)__builtin_amdgcn_s_getreg((3 << 11) | 20) & 0xFu; }
#define XB_SPIN(cond, bar) do { unsigned _sp = 0; while (cond) { __builtin_amdgcn_s_sleep(1); \
    if ((++_sp & 255u) == 0u) { if (xb_ld(&(bar)[XB_TMO])) break; if (_sp > XB_SPIN_CAP) { atomicAdd(&(bar)[XB_TMO], 1u); break; } } } } while (0)

struct XcdBarrier {
    unsigned* bar; unsigned x;
    volatile LAS unsigned* st;
};

__device__ __forceinline__ XcdBarrier xcd_barrier_post(unsigned* bar, volatile LAS unsigned* st) {
    XcdBarrier b; b.bar = bar; b.x = xb_xcc_id(); b.st = st;
    if (threadIdx.x == 0) (void)xb_add(&bar[XB_XCNT(b.x)], 1u);
    return b;
}
__device__ __forceinline__ void xcd_barrier_complete(unsigned* bar, unsigned x, unsigned& nloc, unsigned& nx) {
    const unsigned G = gridDim.x * gridDim.y * gridDim.z;
    unsigned sum, cnt, mine, sp = 0u;
    for (;;) {
        sum = 0u; cnt = 0u; mine = 0u;
#pragma unroll
        for (unsigned j = 0; j < 16; ++j) { const unsigned c = xb_ld(&bar[XB_XCNT(j)]); sum += c; cnt += (c > 0u) ? 1u : 0u; mine = (j == x) ? c : mine; }
        if (sum == G) break;
        __builtin_amdgcn_s_sleep(1);
        if ((++sp & 255u) == 0u) { if (xb_ld(&bar[XB_TMO])) break; if (sp > XB_SPIN_CAP) { atomicAdd(&bar[XB_TMO], 1u); break; } }
    }
    nloc = mine > 0u ? mine : 1u; nx = cnt > 0u ? cnt : 1u;
}

__device__ __forceinline__ void xcd_barrier(const XcdBarrier& b) {
    asm volatile("s_waitcnt vmcnt(0)" ::: "memory");
    __syncthreads();
    if (threadIdx.x == 0) {
        unsigned* bar = b.bar;
        __builtin_amdgcn_s_waitcnt(0);
        unsigned nloc = b.st[0], nx = b.st[1];
        if (nloc == 0u) { xcd_barrier_complete(bar, b.x, nloc, nx); b.st[0] = nloc; b.st[1] = nx; }
        const unsigned old = xb_add(&bar[XB_XSUB(b.x)], 1u);
        const unsigned gen = old / nloc;
        if (old + 1u == (gen + 1u) * nloc) {
            __builtin_amdgcn_fence(__ATOMIC_RELEASE, "agent");
            asm volatile("s_waitcnt vmcnt(0)" ::: "memory");
            const unsigned og = xb_add(&bar[XB_TOP], 1u);
            const unsigned tg = og / nx;
            if (og + 1u == (tg + 1u) * nx) xb_add(&bar[XB_TOPGEN], 1u);
            else XB_SPIN(xb_ld(&bar[XB_TOPGEN]) == tg, bar);
            __builtin_amdgcn_fence(__ATOMIC_ACQUIRE, "agent");
            xb_add(&bar[XB_XGEN(b.x)], 1u);
            asm volatile("s_waitcnt vmcnt(0)" ::: "memory");
        } else {
            XB_SPIN(xb_ld(&bar[XB_XGEN(b.x)]) == gen, bar);
            __builtin_amdgcn_fence(__ATOMIC_ACQUIRE, "agent");
            asm volatile("s_waitcnt vmcnt(0)" ::: "memory");
        }
    }
    __syncthreads();
}

struct Frame {
    LAS unsigned char* lds;
    volatile LAS unsigned* MISC;
    gu32* ctl;
    int tid, lane, wave;
    int vcu, G;
    const float* in[20]; float* out; unsigned char* ws;
};
enum { I_XP = 0, I_XS, I_CPOOL, I_CK, I_CV, I_NMIX, I_WIN, I_WPOOL, I_PSCALE, I_QN, I_KN, I_LQ1, I_LK1, I_LQ2, I_LK2, I_SUBLN, I_WOUT, I_NFFN, I_WFI, I_WFO };

__device__ __forceinline__ float wave_sum(float v) {
#pragma unroll
    for (int o = 1; o < 64; o <<= 1) v += __shfl_xor(v, o);
    return v;
}
__device__ __forceinline__ float wave_max(float v) {
#pragma unroll
    for (int o = 1; o < 64; o <<= 1) v = fmaxf(v, __shfl_xor(v, o));
    return v;
}
__device__ __forceinline__ void unpack8(const v4u w, float (&f)[8]) {
    f[0] = pg8::bf_lo(w.x); f[1] = pg8::bf_hi(w.x); f[2] = pg8::bf_lo(w.y); f[3] = pg8::bf_hi(w.y);
    f[4] = pg8::bf_lo(w.z); f[5] = pg8::bf_hi(w.z); f[6] = pg8::bf_lo(w.w); f[7] = pg8::bf_hi(w.w);
}
__device__ __forceinline__ v4u pack8f(const float (&f)[8]) {
    v4u o; o.x = pg8::cvt_pk_bf16(f[0], f[1]); o.y = pg8::cvt_pk_bf16(f[2], f[3]); o.z = pg8::cvt_pk_bf16(f[4], f[5]); o.w = pg8::cvt_pk_bf16(f[6], f[7]); return o;
}

__device__ __forceinline__ void transpose_item(const float* W, int N, bf16* WT, int Kd, size_t dst_row0, int k0, int n0, LAS float* scr, int lane) {
#pragma unroll 8
    for (int i = 0; i < 32; ++i) { const int kk = 2 * i + (lane >> 5); scr[kk * 33 + (lane & 31)] = W[(size_t)(k0 + kk) * N + n0 + (lane & 31)]; }
    LDS_WAIT(); asm volatile("" ::: "memory");
    const int c = lane & 7;
#pragma unroll
    for (int j = 0; j < 4; ++j) { const int n = (lane >> 3) + 8 * j; const LAS float* s = scr + (8 * c) * 33 + n;
        v4u o; o.x = pg8::cvt_pk_bf16(s[0 * 33], s[1 * 33]); o.y = pg8::cvt_pk_bf16(s[2 * 33], s[3 * 33]); o.z = pg8::cvt_pk_bf16(s[4 * 33], s[5 * 33]); o.w = pg8::cvt_pk_bf16(s[6 * 33], s[7 * 33]);
        *(GAS v4u*)(WT + (dst_row0 + n) * Kd + k0 + 8 * c) = o; }
    LDS_WAIT(); asm volatile("" ::: "memory");
}

__device__ __forceinline__ void rms_row_to_bf16(const float* xrow, const float* g, bf16* orow, int lane) {
    const GAS f32x4* xr = (const GAS f32x4*)xrow + lane; const GAS f32x4* gr = (const GAS f32x4*)g + lane;
    f32x4 v[16]; float s = 0.f;
#pragma unroll
    for (int j = 0; j < 16; ++j) { v[j] = xr[64 * j]; s += (v[j].x * v[j].x + v[j].y * v[j].y) + (v[j].z * v[j].z + v[j].w * v[j].w); }
    const float rs = __builtin_amdgcn_rsqf(wave_sum(s) * (1.f / DM) + EPS);
    GAS unsigned long long* o8 = (GAS unsigned long long*)orow + lane;
#pragma unroll
    for (int j = 0; j < 16; ++j) { const f32x4 gg = gr[64 * j];
        o8[64 * j] = (unsigned long long)pg8::cvt_pk_bf16(v[j].x * rs * gg.x, v[j].y * rs * gg.y) | ((unsigned long long)pg8::cvt_pk_bf16(v[j].z * rs * gg.z, v[j].w * rs * gg.w) << 32); }
}

__device__ __forceinline__ void p0_prologue(Frame& F) {
    LAS float* scr = (LAS float*)(F.lds + RING_OFF + F.wave * 16384);
    const int gw = F.vcu * NWAVES + F.wave, NGW = F.G * NWAVES;
    unsigned char* ws = F.ws;
    constexpr int NB_IN = IN_COLS / 32, I_IN = (DM / 64) * NB_IN;
    constexpr int NB_O = DM / 32, I_O = (DM / 64) * NB_O;
    constexpr int I_FO = (DFF / 64) * NB_O;
    constexpr int NB_P = PG_OUT / 32, I_P1 = (PG_IN / 64) * NB_P, I_P = 4 * I_P1;
    constexpr int NITEMS = I_IN + I_O + I_FO + I_P;
    for (int it = gw; it < NITEMS; it += NGW) {
        int r = it;
        if (r < I_IN) { const int kb = r / NB_IN, nb = r % NB_IN; transpose_item(F.in[I_WIN], IN_COLS, (bf16*)(ws + WS_WIN), DM, (size_t)nb * 32, kb * 64, nb * 32, scr, F.lane); continue; } r -= I_IN;
        if (r < I_O) { const int kb = r / NB_O, nb = r % NB_O; transpose_item(F.in[I_WOUT], DM, (bf16*)(ws + WS_WOUT), DM, (size_t)nb * 32, kb * 64, nb * 32, scr, F.lane); continue; } r -= I_O;
        if (r < I_FO) { const int kb = r / NB_O, nb = r % NB_O; transpose_item(F.in[I_WFO], DM, (bf16*)(ws + WS_WFO), DFF, (size_t)nb * 32, kb * 64, nb * 32, scr, F.lane); continue; } r -= I_FO;
        { const int gI = r / I_P1, q = r % I_P1, kb = q / NB_P, nb = q % NB_P;
          transpose_item(F.in[I_WPOOL] + (size_t)gI * PG_IN * PG_OUT, PG_OUT, (bf16*)(ws + WS_WPOOL) + (size_t)gI * PG_OUT * PG_IN, PG_IN, (size_t)nb * 32, kb * 64, nb * 32, scr, F.lane); }
    }
    for (int m = gw; m < M; m += NGW) {
        const float* xrow = (m < MP) ? F.in[I_XP] + (size_t)m * DM : F.in[I_XS] + (size_t)(m - MP) * DM;
        rms_row_to_bf16(xrow, F.in[I_NMIX], (bf16*)(ws + WS_H) + (size_t)m * DM, F.lane);
    }
    constexpr int CROWS = DEC_B * PAST;
    for (int r = gw; r < 2 * CROWS + 2 * DEC_B * 32; r += NGW) {
        if (r < 2 * CROWS) { const int isv = r >= CROWS, rr = isv ? r - CROWS : r, b = rr / PAST, s = rr % PAST;
            const GAS f32x4* src = (const GAS f32x4*)((isv ? F.in[I_CV] : F.in[I_CK]) + (size_t)rr * DM);
            GAS v4u* dst = (GAS v4u*)((bf16*)(ws + (isv ? WS_SV : WS_SK)) + (size_t)(b * SKROWS + s) * DM);
#pragma unroll
            for (int j = 0; j < 8; ++j) { const int ch = j * 64 + F.lane; const f32x4 a = src[2 * ch], c = src[2 * ch + 1];
                v4u o; o.x = pg8::cvt_pk_bf16(a.x, a.y); o.y = pg8::cvt_pk_bf16(a.z, a.w); o.z = pg8::cvt_pk_bf16(c.x, c.y); o.w = pg8::cvt_pk_bf16(c.z, c.w); dst[ch] = o; }
        } else { const int q = r - 2 * CROWS, isv = q >= DEC_B * 32, qq = isv ? q - DEC_B * 32 : q, b = qq / 32, s = PAST + DEC_T + qq % 32;
            GAS v4u* dst = (GAS v4u*)((bf16*)(ws + (isv ? WS_SV : WS_SK)) + (size_t)(b * SKROWS + s) * DM);
#pragma unroll
            for (int j = 0; j < 8; ++j) dst[j * 64 + F.lane] = (v4u){0u, 0u, 0u, 0u}; }
    }
}

__device__ __forceinline__ void p2_norm_row(Frame& F, int row) {
    unsigned char* ws = F.ws; const int lane = F.lane;
    const bool samp = row >= MP; const int sb = samp ? (row - MP) / DEC_T : 0, st = samp ? (row - MP) % DEC_T : 0;
    float qg[8], kg[8];
    { const GAS f32x4* a = (const GAS f32x4*)(F.in[I_QN] + (lane & 15) * 8); const GAS f32x4* b = (const GAS f32x4*)(F.in[I_KN] + (lane & 15) * 8);
      const f32x4 a0 = a[0], a1 = a[1], b0 = b[0], b1 = b[1];
      qg[0] = a0.x; qg[1] = a0.y; qg[2] = a0.z; qg[3] = a0.w; qg[4] = a1.x; qg[5] = a1.y; qg[6] = a1.z; qg[7] = a1.w;
      kg[0] = b0.x; kg[1] = b0.y; kg[2] = b0.z; kg[3] = b0.w; kg[4] = b1.x; kg[5] = b1.y; kg[6] = b1.z; kg[7] = b1.w; }
    GAS v4u* qrow = (GAS v4u*)((bf16*)(ws + WS_Q) + (size_t)row * DM);
    GAS v4u* krow = (GAS v4u*)((bf16*)(ws + WS_K) + (size_t)row * DM);
    GAS f32x4* nk = (GAS f32x4*)(samp ? F.out + OFF_NKS + (size_t)(row - MP) * DM : F.out + OFF_NKP + (size_t)row * DM);
    GAS v4u* skrow = (GAS v4u*)((bf16*)(ws + WS_SK) + (size_t)(sb * SKROWS + PAST + st) * DM);
#pragma unroll
    for (int j = 0; j < 8; ++j) { const int ch = j * 64 + lane; float f[8]; unpack8(qrow[ch], f);
        float ss = 0.f;
#pragma unroll
        for (int e = 0; e < 8; ++e) ss += f[e] * f[e];
        ss += __shfl_xor(ss, 1); ss += __shfl_xor(ss, 2); ss += __shfl_xor(ss, 4); ss += __shfl_xor(ss, 8);
        const float rs = __builtin_amdgcn_rsqf(ss * (1.f / 128.f) + EPS) * QSCALE;
#pragma unroll
        for (int e = 0; e < 8; ++e) f[e] = f[e] * rs * qg[e];
        qrow[ch] = pack8f(f); }
#pragma unroll
    for (int j = 0; j < 8; ++j) { const int ch = j * 64 + lane; float f[8]; unpack8(krow[ch], f);
        float ss = 0.f;
#pragma unroll
        for (int e = 0; e < 8; ++e) ss += f[e] * f[e];
        ss += __shfl_xor(ss, 1); ss += __shfl_xor(ss, 2); ss += __shfl_xor(ss, 4); ss += __shfl_xor(ss, 8);
        const float rs = __builtin_amdgcn_rsqf(ss * (1.f / 128.f) + EPS);
#pragma unroll
        for (int e = 0; e < 8; ++e) f[e] = f[e] * rs * kg[e];
        nk[2 * ch] = (f32x4){f[0], f[1], f[2], f[3]}; nk[2 * ch + 1] = (f32x4){f[4], f[5], f[6], f[7]};
        const v4u w = pack8f(f); krow[ch] = w; if (samp) skrow[ch] = w; }
    if (samp) { const GAS v4u* vrow = (const GAS v4u*)((const bf16*)(ws + WS_V) + (size_t)row * DM); GAS v4u* svrow = (GAS v4u*)((bf16*)(ws + WS_SV) + (size_t)(sb * SKROWS + PAST + st) * DM);
#pragma unroll
        for (int j = 0; j < 8; ++j) svrow[j * 64 + lane] = vrow[j * 64 + lane]; }
}
template <int G_> __device__ __forceinline__ void p2_pool_group(Frame& F, int row, bool samp, int b, int t) {
    constexpr int W = 2 << G_;
    unsigned char* ws = F.ws; const int lane = F.lane; const int c0 = G_ * PG_IN + lane * 8;
    const bf16* U = (const bf16*)(ws + WS_U);
    float acc[8], cur[8];
#pragma unroll
    for (int e = 0; e < 8; ++e) { acc[e] = 0.f; cur[e] = 0.f; }
#pragma unroll
    for (int i = 0; i < W; ++i) { const int tt = t - i;
        if (tt >= 0) { float f[8]; unpack8(*(const GAS v4u*)(U + (size_t)(row - i) * POOL_IN + c0), f);
#pragma unroll
            for (int e = 0; e < 8; ++e) { acc[e] += f[e]; if (i == 0) cur[e] = f[e]; } }
        else if (samp) { const GAS f32x4* cp = (const GAS f32x4*)(F.in[I_CPOOL] + ((size_t)b * 15 + (15 + tt)) * POOL_IN + c0); const f32x4 a = cp[0], c = cp[1];
            acc[0] += a.x; acc[1] += a.y; acc[2] += a.z; acc[3] += a.w; acc[4] += c.x; acc[5] += c.y; acc[6] += c.z; acc[7] += c.w; } }
    const int cnt = samp ? W : ((t + 1 < W) ? t + 1 : W);
    const float inv = 1.0f / (float)cnt;
    float p[8];
#pragma unroll
    for (int e = 0; e < 8; ++e) p[e] = acc[e] * inv - cur[e];
    *(GAS v4u*)((bf16*)(ws + WS_POOLED) + ((size_t)G_ * M + row) * PG_IN + lane * 8) = pack8f(p);
    float* np = nullptr;
    if (!samp && t >= SEQ - 15) np = F.out + OFF_NPP + ((size_t)b * 15 + (t - (SEQ - 15))) * POOL_IN + c0;
    if (samp && t >= DEC_T - 15) np = F.out + OFF_NPS + ((size_t)b * 15 + (t - (DEC_T - 15))) * POOL_IN + c0;
    if (np) { *(GAS f32x4*)np = (f32x4){cur[0], cur[1], cur[2], cur[3]}; *(GAS f32x4*)(np + 4) = (f32x4){cur[4], cur[5], cur[6], cur[7]}; }
}
__device__ __forceinline__ void p2_thin(Frame& F) {
    const int gw = F.vcu * NWAVES + F.wave, NGW = F.G * NWAVES;
    for (int m = gw; m < M; m += NGW) p2_norm_row(F, m);
    for (int m = gw; m < M; m += NGW) { const bool samp = m >= MP; const int b = samp ? (m - MP) / DEC_T : m / SEQ, t = samp ? (m - MP) % DEC_T : m % SEQ;
        p2_pool_group<0>(F, m, samp, b, t); p2_pool_group<1>(F, m, samp, b, t); p2_pool_group<2>(F, m, samp, b, t); p2_pool_group<3>(F, m, samp, b, t); }
    LAS float* scr = (LAS float*)(F.lds + RING_OFF + F.wave * 16384);
    constexpr int NB = (2 * DFF) / 32, NIT = (DM / 64) * NB;
    for (int it = gw; it < NIT; it += NGW) { const int kb = it / NB, nb = it % NB, n0 = nb * 32; const int up = n0 >= DFF, nn = up ? n0 - DFF : n0;
        const size_t drow = (size_t)256 * (nn / 128) + (up ? 128 : 0) + (nn % 128);
        transpose_item(F.in[I_WFI], 2 * DFF, (bf16*)(F.ws + WS_WIN), DM, drow, kb * 64, n0, scr, F.lane); }
}

__device__ __forceinline__ void p4_combine_row(Frame& F, int row) {
    unsigned char* ws = F.ws; const int lane = F.lane;
    float sub[8];
    { const GAS f32x4* a = (const GAS f32x4*)(F.in[I_SUBLN] + (lane & 31) * 8); const f32x4 a0 = a[0], a1 = a[1];
      sub[0] = a0.x; sub[1] = a0.y; sub[2] = a0.z; sub[3] = a0.w; sub[4] = a1.x; sub[5] = a1.y; sub[6] = a1.z; sub[7] = a1.w; }
    const GAS v4u* orow = (const GAS v4u*)((const bf16*)(ws + WS_Q) + (size_t)row * DM);
    GAS v4u* arow = (GAS v4u*)((bf16*)(ws + WS_GA) + (size_t)row * DM);
    const GAS v4u* brow = (const GAS v4u*)((const bf16*)(ws + WS_GB) + (size_t)row * DM);
#pragma unroll
    for (int j = 0; j < 8; ++j) { const int ch = j * 64 + lane; float f[8], a[8], s[8]; unpack8(orow[ch], f); unpack8(arow[ch], a); unpack8(brow[ch], s);
        float ss = 0.f;
#pragma unroll
        for (int e = 0; e < 8; ++e) ss += f[e] * f[e];
        ss += __shfl_xor(ss, 1); ss += __shfl_xor(ss, 2); ss += __shfl_xor(ss, 4); ss += __shfl_xor(ss, 8); ss += __shfl_xor(ss, 16);
        const float rs = __builtin_amdgcn_rsqf(ss * (1.f / 256.f) + EPS) * 0.8f;
#pragma unroll
        for (int e = 0; e < 8; ++e) a[e] = a[e] + s[e] * (f[e] * rs * sub[e]);
        arow[ch] = pack8f(a); }
}

__device__ __forceinline__ void p3_attention(Frame& F) {
    unsigned char* ws = F.ws;
    float lam, Mshift;
    { const int l2 = F.lane * 2;
      const float s1 = wave_sum(F.in[I_LQ1][l2] * F.in[I_LK1][l2] + F.in[I_LQ1][l2 + 1] * F.in[I_LK1][l2 + 1]);
      const float s2 = wave_sum(F.in[I_LQ2][l2] * F.in[I_LK2][l2] + F.in[I_LQ2][l2 + 1] * F.in[I_LK2][l2 + 1]);
      lam = __expf(s1) - __expf(s2) + 0.2f;
      const float gq = wave_max(fmaxf(fabsf(F.in[I_QN][l2]), fabsf(F.in[I_QN][l2 + 1]))), gk = wave_max(fmaxf(fabsf(F.in[I_KN][l2]), fabsf(F.in[I_KN][l2 + 1])));
      Mshift = MBOUND * gq * gk; }
    const bf16* Qb = (const bf16*)(ws + WS_Q); const bf16* Kb = (const bf16*)(ws + WS_K); const bf16* Vb = (const bf16*)(ws + WS_V);
    const bf16* SKb = (const bf16*)(ws + WS_SK); const bf16* SVb = (const bf16*)(ws + WS_SV);
    for (int v = F.vcu; v < 256; v += F.G) {
        const int xcd = v >> 5, j = v & 31;
        for (int idx = 0; idx < 9; ++idx) {
            da::Unit u;
            if (idx < 8) { const int bh = xcd * 4 + (idx >> 1), b = bh >> 4, h = bh & 15, uq = (idx & 1) ? j : 63 - j;
                u.Q = Qb + ((size_t)b * SEQ + (size_t)uq * 128) * DM + h * 256; u.O = (bf16*)u.Q;
                u.K = Kb + (size_t)b * SEQ * DM + h * 256; u.V = Vb + (size_t)b * SEQ * DM + h * 256;
                u.nt = 2 * uq + 2; u.nt_lo = 2 * uq + 1; u.nt_hi = 2 * uq + 2; u.sample = 0; }
            else { if (v >= 128) break; const int b = v >> 4, h = v & 15;
                u.Q = Qb + ((size_t)MP + (size_t)b * DEC_T) * DM + h * 256; u.O = (bf16*)u.Q;
                u.K = SKb + (size_t)b * SKROWS * DM + h * 256; u.V = SVb + (size_t)b * SKROWS * DM + h * 256;
                u.nt = 17; u.nt_lo = 17; u.nt_hi = 17; u.sample = 1; }
            da::attn_unit(u, F.lds + RING_OFF, lam, Mshift);
        }
    }
}

struct Args { const float* in[20]; float* out; unsigned char* ws; int ph_lo, ph_hi, li, pad; };
__global__ void __launch_bounds__(NWAVES * 64, 2) mk_fwd(Args args) {
    extern __shared__ __attribute__((aligned(16))) unsigned char lds[];
    Frame F;
    F.lds = (LAS unsigned char*)lds;
    F.MISC = (volatile LAS unsigned*)(F.lds + MISC_OFF);
    F.tid = threadIdx.x; F.lane = F.tid & 63; F.wave = __builtin_amdgcn_readfirstlane(F.tid >> 6);
    F.G = gridDim.x; { const int bx = blockIdx.x; F.vcu = (F.G % 8 == 0) ? (bx % 8) * (F.G / 8) + bx / 8 : bx; }
#pragma unroll
    for (int i = 0; i < 20; ++i) F.in[i] = args.in[i];
    F.out = args.out; F.ws = args.ws;
    unsigned char* ws = args.ws;
    F.ctl = (gu32*)(ws + WS_CTL);
    for (int u = F.tid; u < (LDS_BYTES - LDSCTL_OFF) / 4; u += NWAVES * 64) ((LAS unsigned*)(F.lds + LDSCTL_OFF))[u] = 0u;
    __syncthreads();
    XcdBarrier bar; bar.bar = (unsigned*)(F.ctl + CW_BAR); bar.x = 0; bar.st = nullptr;
    if (N_LAUNCHES == 1) bar = xcd_barrier_post((unsigned*)(F.ctl + CW_BAR), F.MISC + 8);
#define GRID_BAR(seam) do { if (N_LAUNCHES != 1) { if (F.tid == 0) __hip_atomic_store(F.ctl + CW_TMO, 0xBADBA0u | (unsigned)(seam), RLX_AGENT); } else { xcd_barrier(bar); } } while (0)
    const int lo = args.ph_lo, hi = args.ph_hi;
#ifndef PH_MASK
#define PH_MASK 0xff
#endif
#define IN(k) (((PH_MASK >> (k)) & 1) && lo <= (k) && (k) < hi)
#define BOTH(k) (IN(k) && IN((k) + 1))
    bf16* const Wt_in = (bf16*)(ws + WS_WIN); bf16* const Hb = (bf16*)(ws + WS_H);
    float* const rowss = (float*)(ws + WS_CTL) + CW_ROWSS;

    if (IN(0)) { p0_prologue(F); if (BOTH(0)) GRID_BAR(0); }

    if (IN(1)) {
        pg8::Gemm g{Hb, Wt_in, M, IN_COLS, DM, 0, 0}; pg8::StaticOrder S; S.init(M, IN_COLS, F.G, (int)blockIdx.x);
        pg8::EpiInProj E{(bf16*)(ws + WS_U), (bf16*)(ws + WS_Q), (bf16*)(ws + WS_K), (bf16*)(ws + WS_V), (bf16*)(ws + WS_GA), (bf16*)(ws + WS_GB), F.out + OFF_NVP, F.out + OFF_NVS};
        pg8::gemm_phase<pg8::EpiInProj, pg8::StaticOrder, true, true>(F.lds + RING_OFF, g, S, E);
        if (BOTH(1)) GRID_BAR(1);
    }

    if (IN(2)) { p2_thin(F); if (BOTH(2)) GRID_BAR(2); }

    if (IN(3)) {
        { pg8::Gemm g{(bf16*)(ws + WS_POOLED), (bf16*)(ws + WS_WPOOL), M, 4 * PG_OUT, PG_IN, (size_t)M * PG_IN * 2, 4}; pg8::StaticOrder S; S.init(M, 4 * PG_OUT, F.G, (int)blockIdx.x);
          pg8::EpiPool E{(bf16*)(ws + WS_GA), F.in[I_PSCALE]};
          pg8::gemm_phase<pg8::EpiPool, pg8::StaticOrder, true, true>(F.lds + RING_OFF, g, S, E); }
        p3_attention(F);
        if (BOTH(3)) GRID_BAR(3);
    }

    if (IN(4)) { const int gw = F.vcu * NWAVES + F.wave, NGW = F.G * NWAVES;
        for (int m = gw; m < M; m += NGW) p4_combine_row(F, m);
        if (BOTH(4)) GRID_BAR(4); }

    if (IN(5)) {
        pg8::Gemm g{(bf16*)(ws + WS_GA), (bf16*)(ws + WS_WOUT), M, DM, DM, 0, 0}; pg8::StaticOrder S; S.init(M, DM, F.G, (int)blockIdx.x);
        pg8::EpiWout E{F.in[I_XP], F.in[I_XS], F.out + OFF_Y, Hb, F.in[I_NFFN], rowss};
        pg8::gemm_phase<pg8::EpiWout, pg8::StaticOrder, true, true>(F.lds + RING_OFF, g, S, E);
        if (BOTH(5)) GRID_BAR(5);
    }

    if (IN(6)) {
        pg8::Gemm g{Hb, Wt_in, M, 2 * DFF, DM, 0, 0}; pg8::StaticOrder S; S.init(M, 2 * DFF, F.G, (int)blockIdx.x);
        pg8::EpiSwiGLU E{(bf16*)(ws + WS_HFF), rowss};
        pg8::gemm_phase<pg8::EpiSwiGLU, pg8::StaticOrder, true, true>(F.lds + RING_OFF, g, S, E);
        if (BOTH(6)) GRID_BAR(6);
    }

    if (IN(7)) {
        pg8::Gemm g{(bf16*)(ws + WS_HFF), (bf16*)(ws + WS_WFO), M, DM, DFF, 0, 0}; pg8::StaticOrder S; S.init(M, DM, F.G, (int)blockIdx.x);
        pg8::EpiFfnOut E{F.out + OFF_Y};
        pg8::gemm_phase<pg8::EpiFfnOut, pg8::StaticOrder, true, true>(F.lds + RING_OFF, g, S, E);
    }
#undef IN
#undef BOTH
#undef GRID_BAR
}

extern "C" void kernel_launch(void* const* d_in, const int* in_sizes, int n_in, void* d_out, int out_size, void* d_ws, size_t ws_size, hipStream_t stream) {
    static int grid = 0;
    if (grid == 0) {
        if (n_in != 20 || in_sizes[0] != MP * DM || (size_t)out_size != OUT_SIZE || ws_size < WS_END) {
            fprintf(stderr, "kernel_launch: shape mismatch: n_in %d in0 %d out %d ws %zu (need >= %zu); nothing launched\n", n_in, n_in > 0 ? in_sizes[0] : -1, out_size, ws_size, (size_t)WS_END); grid = -1; return; }
        int dev = 0, cus = 0, per_cu = 0;
        if (hipGetDevice(&dev) != hipSuccess || hipDeviceGetAttribute(&cus, hipDeviceAttributeMultiprocessorCount, dev) != hipSuccess) { fprintf(stderr, "kernel_launch: device query failed\n"); grid = -1; return; }
        if (hipFuncSetAttribute((const void*)mk_fwd, hipFuncAttributeMaxDynamicSharedMemorySize, LDS_BYTES) != hipSuccess) { fprintf(stderr, "kernel_launch: hipFuncSetAttribute failed\n"); grid = -1; return; }
        if (hipOccupancyMaxActiveBlocksPerMultiprocessor(&per_cu, (const void*)mk_fwd, NWAVES * 64, LDS_BYTES) != hipSuccess || per_cu < 1)
            fprintf(stderr, "kernel_launch: note: occupancy query reports %d workgroups per CU\n", per_cu);
        (void)hipGetLastError();
        grid = cus;
    }
    if (grid < 0) return;
    if (hipMemsetAsync((char*)d_ws + WS_CTL, 0, CTL_ZERO_BYTES, stream) != hipSuccess) { fprintf(stderr, "kernel_launch: hipMemsetAsync failed\n"); return; }
    Args a{};
    for (int i = 0; i < 20; ++i) a.in[i] = (const float*)d_in[i];
    a.out = (float*)d_out; a.ws = (unsigned char*)d_ws;
    for (int li = 0; li < N_LAUNCHES; ++li) {
        a.ph_lo = (N_LAUNCHES == 1) ? 0 : li; a.ph_hi = (N_LAUNCHES == 1) ? N_PHASES : li + 1; a.li = li; a.pad = 0;
        hipLaunchKernelGGL(mk_fwd, dim3(grid), dim3(NWAVES * 64), LDS_BYTES, stream, a);
        const hipError_t le = hipPeekAtLastError();
        if (le != hipSuccess) { fprintf(stderr, "kernel_launch: launch %d failed: %s\n", li, hipGetErrorName(le)); break; }
    }
}
```

```cpp
#include <hip/hip_runtime.h>
#include <cstdio>
#include <cstdint>
namespace pg8 {
#define PG8_LAS __attribute__((address_space(3)))
typedef unsigned short bf16_t;
typedef short bf16x8 __attribute__((ext_vector_type(8)));
typedef float f32x4 __attribute__((ext_vector_type(4)));
typedef unsigned u32x4 __attribute__((ext_vector_type(4)));
constexpr int BM = 256, BK = 64, HALF = 128, HTB = HALF * BK * 2  , STAGE_BYTES = 8 * HTB, NXCD = 8, WGM = 8;

__host__ __device__ __forceinline__ int lds_byte(int r, int c) { const int st = (r >> 4) * 2 + (c >> 5), rr = r & 15, cc = c & 31, ob = rr * 64 + cc * 2; return st * 1024 + (ob ^ (((ob >> 9) & 1) << 5)); }
__host__ __device__ __forceinline__ void stage_rc(int b, int& R, int& C) { const int st = b / 1024, sb = b % 1024, swz = sb ^ (((sb >> 9) & 1) << 5); R = (st >> 1) * 16 + swz / 64; C = (st & 1) * 32 + (swz % 64) / 2; }
__host__ __device__ __forceinline__ int perm32(int rho) { const int n = rho >> 4, i = rho & 15; return 8 * (i >> 2) + 4 * n + (i & 3); }

struct Unit { int pm, pn, kt0, knt, ks; };
struct Gemm { const bf16_t* A; const bf16_t* Bt; int M, N, K; size_t a_gbytes; int npg; };

struct StaticOrder {
    int nM, nN, nwg, G, c, wgm;
    __host__ __device__ void init(int M, int N, int G_, int c_, int wgm_ = WGM) { nM = M / BM; nN = N / BM; nwg = nM * nN; G = G_; c = c_; wgm = wgm_; }
    __host__ __device__ __forceinline__ bool next(int i, Unit& u) const {
        const long L = (long)i * G + c; if (L >= nwg) return false;
        int wgid = (int)L; { const int q = nwg / NXCD, r = nwg % NXCD, xcd = wgid % NXCD, off = wgid / NXCD; wgid = (xcd < r ? xcd * (q + 1) : r * (q + 1) + (xcd - r) * q) + off; }
        const int nig = wgm * nN, gid = wgid / nig, fm = gid * wgm, gsz = (nM - fm) < wgm ? (nM - fm) : wgm;
        u.pm = fm + ((wgid % nig) % gsz); u.pn = (wgid % nig) / gsz; u.kt0 = 0; u.knt = 0; u.ks = 0; return true;
    }
    __device__ __forceinline__ void a_ready(const Unit&) const {}
    __device__ __forceinline__ void done(const Unit&) const {}
};

struct AbsOrder {
    StaticOrder so; int c, nabs, R, rem;
    __host__ __device__ static int fit(int nwg, int G, int want) { const int R = nwg / G, rem = nwg % G; int n = want; if (n < 0) n = 0; while (n > 0 && !(rem <= G - n && G - n - rem >= n * R)) --n; return n; }
    __host__ __device__ void init(int M, int N, int G_, int c_, int nabs_, int wgm_ = WGM) { so.init(M, N, G_, 0, wgm_); c = c_; nabs = nabs_; R = so.nwg / G_; rem = so.nwg % G_; }
    __host__ __device__ __forceinline__ bool next(int i, Unit& u) const {
        if (c >= so.G - nabs) return false;
        StaticOrder t = so;
        if (i < R) { t.c = c; return t.next(i, u); }
        if (i > R) return false;
        if (c < rem) { t.c = c; return t.next(R, u); }
        const int o = c - rem; if (nabs == 0 || o >= nabs * R) return false;
        t.c = so.G - nabs + o % nabs; return t.next(o / nabs, u);
    }
    __device__ __forceinline__ void a_ready(const Unit&) const {}
    __device__ __forceinline__ void done(const Unit&) const {}
};

struct SplitOrder {
    StaticOrder so; int G, c, npn, nsplit, nt_full;
    __host__ __device__ void init(int Mp, int N, int K, int G_, int c_, int nsplit_, int wgm_ = WGM) { so.init(Mp, N, G_, c_, wgm_); G = G_; c = c_; npn = N / BM; nsplit = nsplit_; nt_full = K / BK; }
    __host__ __device__ __forceinline__ int kt_of(int s) const { const int pairs = nt_full / 2, q = pairs / nsplit, r = pairs % nsplit; return 2 * (s * q + (s < r ? s : r)); }
    __host__ __device__ __forceinline__ bool next(int i, Unit& u) const {
        if (so.next(i, u)) return true;
        const long L = (long)i * G + c - so.nwg; if (L < 0 || L >= (long)npn * nsplit) return false;
        const int s = (int)L / npn; u.pm = so.nM; u.pn = (int)L % npn; u.kt0 = kt_of(s); u.knt = kt_of(s + 1) - u.kt0; u.ks = s; return true;
    }
    __device__ __forceinline__ void a_ready(const Unit&) const {}
    __device__ __forceinline__ void done(const Unit&) const {}
};

struct QuadOrder {
    int nquad, G, c, nfull, nown, nleft4;
    __host__ __device__ void init(int M, int G_, int c_) { nquad = (M / BM) * 4; G = G_; c = c_; nown = nquad / G; nfull = nown * G; nleft4 = 4 * (nquad - nfull); }
    __host__ __device__ __forceinline__ bool has_left() const { return c < nleft4; }
    __host__ __device__ __forceinline__ int left_quad() const { return nfull + (c >> 2); }
    __host__ __device__ __forceinline__ bool next(int i, Unit& u) const {
        int quad, sub;
        if (i < 4 * nown) { quad = c + (i >> 2) * G; sub = i & 3; }
        else if (i == 4 * nown && has_left()) { quad = left_quad(); sub = c & 3; }
        else return false;
        u.pm = quad >> 2; u.pn = (quad & 3) * 4 + sub; u.kt0 = 0; u.knt = 0; u.ks = 0; return true;
    }
    __device__ __forceinline__ void a_ready(const Unit&) const {}
    __device__ __forceinline__ void done(const Unit&) const {}
};
typedef float f32x2 __attribute__((ext_vector_type(2)));
typedef __bf16 bf16x2_t __attribute__((ext_vector_type(2)));
__device__ __forceinline__ unsigned cvt_pk_bf16(float lo, float hi) { f32x2 v = {lo, hi}; bf16x2_t b = __builtin_convertvector(v, bf16x2_t); return __builtin_bit_cast(unsigned, b); }
__device__ __forceinline__ float bf_lo(unsigned w) { return __uint_as_float(w << 16); }
__device__ __forceinline__ float bf_hi(unsigned w) { return __uint_as_float(w & 0xffff0000u); }
__device__ __forceinline__ float fsigmoid(float x) { return __builtin_amdgcn_rcpf(1.0f + __builtin_amdgcn_exp2f(-1.4426950408889634f * x)); }
__device__ __forceinline__ u32x4 pack8(const f32x4 a, const f32x4 b) { u32x4 w; w.x = cvt_pk_bf16(a[0], a[1]); w.y = cvt_pk_bf16(a[2], a[3]); w.z = cvt_pk_bf16(b[0], b[1]); w.w = cvt_pk_bf16(b[2], b[3]); return w; }

struct EpiInProj {
    static constexpr bool PERM = true, AFTER_DRAIN = false;
    bf16_t *U, *Q, *K, *V, *GA, *GB, *SK, *SV; float *nv_p, *nv_s, *nk_p, *nk_s; const float *qg, *kg; PG8_LAS float* xs; float qscale;
    __device__ __forceinline__ void operator()(const f32x4 (&acc)[2][2][4][2], const Unit& u, int wr, int wc, int fr, int fq) const {
        asm volatile("" : "+v"(fr), "+v"(fq));
        const int pn = u.pn; bf16_t* base; int ldc = 4096, ct, type = 0;
        if (pn < 8) { base = U; ldc = 2048; ct = pn; }
        else if (pn < 24) { base = Q; ct = pn - 8; type = 3; }
        else if (pn < 40) { base = K; ct = pn - 24; type = 4; }
        else if (pn < 56) { base = V; ct = pn - 40; type = 1; }
        else if (pn < 72) { base = GA; ct = pn - 56; type = 2; }
        else { base = GB; ct = pn - 72; type = 2; }
        const bool samp = u.pm >= 64;
        const int rt0 = wr * 64 + fr, row0 = u.pm * BM + rt0, col0 = ct * BM + wc * 32 + 8 * fq;
        if (type >= 3) {
#pragma unroll
            for (int ai = 0; ai < 2; ++ai)
#pragma unroll
                for (int m = 0; m < 4; ++m) {
#pragma unroll
                    for (int bj = 0; bj < 2; ++bj) { const f32x4 a = acc[ai][bj][m][0], b = acc[ai][bj][m][1];
                        float s = (a[0] * a[0] + a[1] * a[1]) + (a[2] * a[2] + a[3] * a[3]) + (b[0] * b[0] + b[1] * b[1]) + (b[2] * b[2] + b[3] * b[3]);
                        s += __shfl_xor(s, 16); s += __shfl_xor(s, 32);
                        if (fq == 0) xs[((rt0 + ai * HALF + m * 16) * 2 + bj) * 4 + wc] = s; }
                    asm volatile("" ::: "memory"); }
            asm volatile("s_waitcnt lgkmcnt(0)\n\ts_barrier" ::: "memory");
            const float* gp = (type == 3 ? qg : kg) + wc * 32 + 8 * fq; const f32x4 g0 = *(const f32x4*)gp, g1 = *(const f32x4*)(gp + 4);
            const float sc = (type == 3) ? qscale : 1.0f;
            float* nk = samp ? nk_s + (size_t)(row0 - 16384) * 4096 : nk_p + (size_t)row0 * 4096;
#pragma unroll
            for (int ai = 0; ai < 2; ++ai)
#pragma unroll
                for (int m = 0; m < 4; ++m) { const int rt = rt0 + ai * HALF + m * 16; bf16_t* rowp = base + ((size_t)u.pm * BM + rt) * 4096 + col0;
                    bf16_t* skp = SK + ((size_t)(rt >> 5) * 1088 + 1024 + (rt & 31)) * 4096 + col0;
#pragma unroll
                    for (int bj = 0; bj < 2; ++bj) { const f32x4 t = *(const PG8_LAS f32x4*)(xs + (rt * 2 + bj) * 4);
                        const float rs = __builtin_amdgcn_rsqf(((t[0] + t[1]) + (t[2] + t[3])) * (1.0f / 128.0f) + 1e-6f) * sc;
                        const f32x4 v0 = acc[ai][bj][m][0] * rs * g0, v1 = acc[ai][bj][m][1] * rs * g1;
                        const u32x4 w = pack8(v0, v1);
                        *(u32x4*)(rowp + bj * HALF) = w;
                        if (type == 4) { float* kp = nk + (size_t)(ai * HALF + m * 16) * 4096 + col0 + bj * HALF; *(f32x4*)kp = v0; *(f32x4*)(kp + 4) = v1;
                            if (samp) *(u32x4*)(skp + bj * HALF) = w; } }
                    asm volatile("" ::: "memory"); }
            return;
        }
        float* vout = samp ? nv_s + (size_t)(row0 - 16384) * 4096 : nv_p + (size_t)row0 * 4096;
#pragma unroll
        for (int ai = 0; ai < 2; ++ai)
#pragma unroll
            for (int m = 0; m < 4; ++m) { const size_t roff = (size_t)(ai * HALF + m * 16); bf16_t* rowp = base + ((size_t)row0 + roff) * ldc + col0;
                const int rt = rt0 + ai * HALF + m * 16; bf16_t* svp = SV + ((size_t)(rt >> 5) * 1088 + 1024 + (rt & 31)) * 4096 + col0;
#pragma unroll
                for (int bj = 0; bj < 2; ++bj) { f32x4 v0 = acc[ai][bj][m][0], v1 = acc[ai][bj][m][1];
                    if (type == 1) { float* vp = vout + roff * 4096 + col0 + bj * HALF; *(f32x4*)vp = v0; *(f32x4*)(vp + 4) = v1; }
                    if (type == 2) {
#pragma unroll
                        for (int e = 0; e < 4; ++e) { v0[e] = fsigmoid(v0[e]); v1[e] = fsigmoid(v1[e]); } }
                    const u32x4 w = pack8(v0, v1);
                    *(u32x4*)(rowp + bj * HALF) = w;
                    if (type == 1 && samp) *(u32x4*)(svp + bj * HALF) = w; } }
    }
};

struct EpiPool {
    static constexpr bool PERM = true, AFTER_DRAIN = false;
    bf16_t* GA; const float* pscale;
    __device__ __forceinline__ void operator()(const f32x4 (&acc)[2][2][4][2], const Unit& u, int wr, int wc, int fr, int fq) const {
        asm volatile("" : "+v"(fr), "+v"(fq));
        const int row0 = u.pm * BM + wr * 64 + fr, col0 = u.pn * BM + wc * 32 + 8 * fq;
        f32x4 ps[2][2];
#pragma unroll
        for (int bj = 0; bj < 2; ++bj)
#pragma unroll
            for (int n = 0; n < 2; ++n) ps[bj][n] = *(const f32x4*)(pscale + col0 + bj * HALF + 4 * n);
        u32x4 gwv[2][4][2];
#pragma unroll
        for (int ai = 0; ai < 2; ++ai)
#pragma unroll
            for (int m = 0; m < 4; ++m)
#pragma unroll
                for (int bj = 0; bj < 2; ++bj) gwv[ai][m][bj] = *(const u32x4*)(GA + (size_t)(row0 + ai * HALF + m * 16) * 4096 + col0 + bj * HALF);
#pragma unroll
        for (int ai = 0; ai < 2; ++ai)
#pragma unroll
            for (int m = 0; m < 4; ++m) { bf16_t* rowp = GA + (size_t)(row0 + ai * HALF + m * 16) * 4096 + col0;
#pragma unroll
                for (int bj = 0; bj < 2; ++bj) { const u32x4 gw = gwv[ai][m][bj];
                    f32x4 v0 = acc[ai][bj][m][0] * ps[bj][0], v1 = acc[ai][bj][m][1] * ps[bj][1];
                    v0[0] *= bf_lo(gw.x); v0[1] *= bf_hi(gw.x); v0[2] *= bf_lo(gw.y); v0[3] *= bf_hi(gw.y);
                    v1[0] *= bf_lo(gw.z); v1[1] *= bf_hi(gw.z); v1[2] *= bf_lo(gw.w); v1[3] *= bf_hi(gw.w);
                    *(u32x4*)(rowp + bj * HALF) = pack8(v0, v1); } }
    }
};

struct EpiWout {
    static constexpr bool PERM = true, AFTER_DRAIN = false;
    const float *xp, *xs; float* y; bf16_t* X1n; const float* gffn; float* rowss;
    __device__ __forceinline__ void operator()(const f32x4 (&acc)[2][2][4][2], const Unit& u, int wr, int wc, int fr, int fq) const {
        asm volatile("" : "+v"(fr), "+v"(fq));
        const int row0 = u.pm * BM + wr * 64 + fr, col0 = u.pn * BM + wc * 32 + 8 * fq;
        const float* xb = (u.pm < 64) ? xp + (size_t)row0 * 4096 : xs + (size_t)(row0 - 16384) * 4096;
        f32x4 gf[2][2];
#pragma unroll
        for (int bj = 0; bj < 2; ++bj)
#pragma unroll
            for (int n = 0; n < 2; ++n) gf[bj][n] = *(const f32x4*)(gffn + col0 + bj * HALF + 4 * n);
#pragma unroll
        for (int ai = 0; ai < 2; ++ai) {
            f32x4 xv[4][2][2];
#pragma unroll
            for (int m = 0; m < 4; ++m)
#pragma unroll
                for (int bj = 0; bj < 2; ++bj) { const float* p = xb + (size_t)(ai * HALF + m * 16) * 4096 + col0 + bj * HALF; xv[m][bj][0] = *(const f32x4*)p; xv[m][bj][1] = *(const f32x4*)(p + 4); }
#pragma unroll
            for (int m = 0; m < 4; ++m) { const size_t roff = (size_t)(ai * HALF + m * 16); float ss = 0.f;
#pragma unroll
                for (int bj = 0; bj < 2; ++bj) { const int c = col0 + bj * HALF;
                    const f32x4 a = xv[m][bj][0] + acc[ai][bj][m][0], b = xv[m][bj][1] + acc[ai][bj][m][1];
                    float* yp = y + ((size_t)row0 + roff) * 4096 + c; *(f32x4*)yp = a; *(f32x4*)(yp + 4) = b;
                    ss += (a[0] * a[0] + a[1] * a[1]) + (a[2] * a[2] + a[3] * a[3]) + (b[0] * b[0] + b[1] * b[1]) + (b[2] * b[2] + b[3] * b[3]);
                    *(u32x4*)(X1n + ((size_t)row0 + roff) * 4096 + c) = pack8(a * gf[bj][0], b * gf[bj][1]); }
                ss += __shfl_xor(ss, 16); ss += __shfl_xor(ss, 32);
                if (fq == 0) (void)__hip_atomic_fetch_add(rowss + row0 + (int)roff, ss, __ATOMIC_RELAXED, __HIP_MEMORY_SCOPE_AGENT); }
            asm volatile("" ::: "memory"); }
    }
};

struct EpiSwiGLU {
    static constexpr bool PERM = true, AFTER_DRAIN = false;
    bf16_t* Hff; const float* rowss;
    __device__ __forceinline__ void operator()(const f32x4 (&acc)[2][2][4][2], const Unit& u, int wr, int wc, int fr, int fq) const {
        asm volatile("" : "+v"(fr), "+v"(fq));
        const int row0 = u.pm * BM + wr * 64 + fr, col0 = u.pn * HALF + wc * 32 + 8 * fq;
        float ssq[2][4];
#pragma unroll
        for (int ai = 0; ai < 2; ++ai)
#pragma unroll
            for (int m = 0; m < 4; ++m) ssq[ai][m] = __hip_atomic_load(rowss + row0 + ai * HALF + m * 16, __ATOMIC_RELAXED, __HIP_MEMORY_SCOPE_AGENT);
#pragma unroll
        for (int ai = 0; ai < 2; ++ai)
#pragma unroll
            for (int m = 0; m < 4; ++m) { const int r = row0 + ai * HALF + m * 16;
                const float rs = __builtin_amdgcn_rsqf(ssq[ai][m] * (1.0f / 4096.0f) + 1e-6f);
                f32x4 g0 = acc[ai][0][m][0] * rs, g1 = acc[ai][0][m][1] * rs, u0 = acc[ai][1][m][0] * rs, u1 = acc[ai][1][m][1] * rs;
#pragma unroll
                for (int e = 0; e < 4; ++e) { g0[e] = g0[e] * fsigmoid(g0[e]) * u0[e]; g1[e] = g1[e] * fsigmoid(g1[e]) * u1[e]; }
                *(u32x4*)(Hff + (size_t)r * 11008 + col0) = pack8(g0, g1); }
    }
};

struct EpiFfnOut {
    static constexpr bool PERM = true, AFTER_DRAIN = false;
    float* y; float* part;
    __device__ __forceinline__ void operator()(const f32x4 (&acc)[2][2][4][2], const Unit& u, int wr, int wc, int fr, int fq) const {
        asm volatile("" : "+v"(fr), "+v"(fq));
        const int rt0 = wr * 64 + fr, col0 = u.pn * BM + wc * 32 + 8 * fq;
        if (u.knt == 0) {
#pragma unroll
            for (int ai = 0; ai < 2; ++ai) {
                f32x4 yv[4][2][2];
#pragma unroll
                for (int m = 0; m < 4; ++m)
#pragma unroll
                    for (int bj = 0; bj < 2; ++bj) { const float* rp = y + (size_t)(u.pm * BM + rt0 + ai * HALF + m * 16) * 4096 + col0 + bj * HALF; yv[m][bj][0] = *(const f32x4*)rp; yv[m][bj][1] = *(const f32x4*)(rp + 4); }
#pragma unroll
                for (int m = 0; m < 4; ++m)
#pragma unroll
                    for (int bj = 0; bj < 2; ++bj) { float* rp = y + (size_t)(u.pm * BM + rt0 + ai * HALF + m * 16) * 4096 + col0 + bj * HALF;
                        *(f32x4*)rp = yv[m][bj][0] + acc[ai][bj][m][0]; *(f32x4*)(rp + 4) = yv[m][bj][1] + acc[ai][bj][m][1]; }
                asm volatile("" ::: "memory"); }
        } else {
#pragma unroll
            for (int ai = 0; ai < 2; ++ai)
#pragma unroll
                for (int m = 0; m < 4; ++m) { float* rp = part + ((size_t)u.ks * BM + rt0 + ai * HALF + m * 16) * 4096 + col0;
#pragma unroll
                    for (int bj = 0; bj < 2; ++bj) { *(f32x4*)(rp + bj * HALF) = acc[ai][bj][m][0]; *(f32x4*)(rp + bj * HALF + 4) = acc[ai][bj][m][1]; } }
        }
    }
};

template <class Epi, class Sched, bool ALIGN_EPI = false, bool SP2 = false>
__device__ __forceinline__ void gemm_phase(PG8_LAS unsigned char* lds, const Gemm g, const Sched& S, const Epi& E) {
    const int tid = threadIdx.x, wid = __builtin_amdgcn_readfirstlane(tid >> 6), lane = tid & 63, wr = wid >> 2, wc = wid & 3, fr = lane & 15, fq = lane >> 4;
    const int K = g.K, nt_full = K / BK;
    unsigned voffA[2], voffB[2];
#pragma unroll
    for (int i = 0; i < 2; ++i) { int R, C; stage_rc(tid * 16 + i * 8192, R, C); const int Rb = Epi::PERM ? ((R & ~31) + perm32(R & 31)) : R;
        voffA[i] = (unsigned)(R * K + C) * 2u; voffB[i] = (unsigned)(Rb * K + C) * 2u; }
    const size_t kstep = (size_t)(BK * 2);
    const size_t hstep = (size_t)HALF * K * 2;
    const size_t tstep = 2 * hstep;
    const unsigned ldsw = (unsigned)wid * 1024u;
    const int aoff = lds_byte(wr * 64 + fr, fq * 8), boff = lds_byte(wc * 32 + fr, fq * 8);
#define PG8_SA(b, h) (((b) * 2 + (h)) * HTB)
#define PG8_SB(b, h) ((4 + (b) * 2 + (h)) * HTB)
#define PG8_STAGE(bufoff, gbase, voff) do { _Pragma("unroll") for (int _i = 0; _i < 2; ++_i) \
        __builtin_amdgcn_global_load_lds((const unsigned*)((const char*)(gbase) + (voff)[_i]), (PG8_LAS unsigned*)(lds + (bufoff) + ldsw + _i * 8192), 16, 0, 0); } while (0)
#define PG8_LDA(dst, b, h) do { _Pragma("unroll") for (int m = 0; m < 4; ++m) _Pragma("unroll") for (int k = 0; k < 2; ++k) dst[m][k] = *(const PG8_LAS bf16x8*)(lds + PG8_SA(b, h) + aoff + m * 2048 + k * 1024); } while (0)
#define PG8_LDB(dst, b, h) do { _Pragma("unroll") for (int n = 0; n < 2; ++n) _Pragma("unroll") for (int k = 0; k < 2; ++k) dst[n][k] = *(const PG8_LAS bf16x8*)(lds + PG8_SB(b, h) + boff + n * 2048 + k * 1024); } while (0)
#define PG8_MMA(ai, bj, At, Bt) do { __builtin_amdgcn_s_setprio(1); _Pragma("unroll") for (int m = 0; m < 4; ++m) _Pragma("unroll") for (int n = 0; n < 2; ++n) _Pragma("unroll") for (int k = 0; k < 2; ++k) \
        acc[ai][bj][m][n] = __builtin_amdgcn_mfma_f32_16x16x32_bf16(Bt[n][k], At[m][k], acc[ai][bj][m][n], 0, 0, 0); __builtin_amdgcn_s_setprio(0); } while (0)
#define PG8_WAIT_V(n) asm volatile("s_waitcnt vmcnt(" #n ")" ::: "memory")
#define PG8_WAIT_L(n) asm volatile("s_waitcnt lgkmcnt(" #n ")" ::: "memory")
#define PG8_BAR __builtin_amdgcn_s_barrier()
#define PG8_SCHED __builtin_amdgcn_sched_barrier(0)
    Unit cur = {0, 0, 0, 0, 0}, nxt = {0, 0, 0, 0, 0}; int ui = 0;
    if (!S.next(0, cur)) return;
    f32x4 acc[2][2][4][2];
#pragma unroll
    for (int a = 0; a < 2; ++a)
#pragma unroll
        for (int b = 0; b < 2; ++b)
#pragma unroll
            for (int m = 0; m < 4; ++m)
#pragma unroll
                for (int n = 0; n < 2; ++n) acc[a][b][m][n] = (f32x4){0.f, 0.f, 0.f, 0.f};
    bf16x8 At[4][2], B0[2][2], B1[2][2];
    const char* cA = (const char*)g.A + (size_t)cur.pm * tstep + (g.npg ? (size_t)(cur.pn / g.npg) * g.a_gbytes : (size_t)0) + (size_t)cur.kt0 * kstep; const char* cB = (const char*)g.Bt + (size_t)cur.pn * tstep + (size_t)cur.kt0 * kstep;
    S.a_ready(cur);
    if constexpr (SP2) {
        PG8_STAGE(PG8_SB(0, 0), cB, voffB); PG8_STAGE(PG8_SB(0, 1), cB + hstep, voffB); PG8_STAGE(PG8_SA(0, 0), cA, voffA); PG8_STAGE(PG8_SA(0, 1), cA + hstep, voffA);
        if (wr == 1) PG8_BAR;
        PG8_WAIT_V(2); PG8_BAR;
        PG8_STAGE(PG8_SB(1, 0), cB + kstep, voffB); PG8_STAGE(PG8_SA(1, 0), cA + kstep, voffA); PG8_STAGE(PG8_SB(1, 1), cB + hstep + kstep, voffB);
        PG8_WAIT_V(6); PG8_BAR;
    } else {
        PG8_STAGE(PG8_SB(0, 0), cB, voffB); PG8_STAGE(PG8_SA(0, 0), cA, voffA); PG8_STAGE(PG8_SB(0, 1), cB + hstep, voffB); PG8_STAGE(PG8_SA(0, 1), cA + hstep, voffA);
        if (wr == 1) PG8_BAR;
        PG8_WAIT_V(4); PG8_BAR;
        PG8_STAGE(PG8_SB(1, 0), cB + kstep, voffB); PG8_STAGE(PG8_SA(1, 0), cA + kstep, voffA); PG8_STAGE(PG8_SB(1, 1), cB + hstep + kstep, voffB);
        PG8_WAIT_V(6); PG8_BAR;
    }
    for (;;) {
        const bool has_next = S.next(ui + 1, nxt);
        const char* nA = has_next ? (const char*)g.A + (size_t)nxt.pm * tstep + (g.npg ? (size_t)(nxt.pn / g.npg) * g.a_gbytes : (size_t)0) + (size_t)nxt.kt0 * kstep : cA; const char* nB = has_next ? (const char*)g.Bt + (size_t)nxt.pn * tstep + (size_t)nxt.kt0 * kstep : cB;
        const int nt = cur.knt ? cur.knt : nt_full;
        for (int t = 0; t < nt; t += 2) {
            const bool last = (t == nt - 2);
            const char* a1 = cA + (size_t)(t + 1) * kstep;
            const char* a2 = last ? nA : cA + (size_t)(t + 2) * kstep; const char* b2 = last ? nB : cB + (size_t)(t + 2) * kstep;
            const char* a3 = a2 + kstep; const char* b3 = b2 + kstep;
            if (last && has_next) S.a_ready(nxt);
            if constexpr (SP2) {
            PG8_LDB(B0, 0, 0); PG8_LDB(B1, 0, 1); PG8_SCHED; PG8_LDA(At, 0, 0); PG8_STAGE(PG8_SA(1, 1), a1 + hstep, voffA);
            PG8_WAIT_V(8); PG8_WAIT_L(0); PG8_BAR; PG8_MMA(0, 0, At, B0); PG8_MMA(0, 1, At, B1); PG8_BAR; PG8_SCHED;
            PG8_LDA(At, 0, 1); PG8_STAGE(PG8_SB(0, 0), b2, voffB); PG8_STAGE(PG8_SB(0, 1), b2 + hstep, voffB); PG8_STAGE(PG8_SA(0, 0), a2, voffA);
            PG8_WAIT_V(8); PG8_WAIT_L(0); PG8_BAR; PG8_MMA(1, 0, At, B0); PG8_MMA(1, 1, At, B1); PG8_BAR; PG8_SCHED;
            PG8_LDB(B0, 1, 0); PG8_LDB(B1, 1, 1); PG8_SCHED; PG8_LDA(At, 1, 0); PG8_STAGE(PG8_SA(0, 1), a2 + hstep, voffA);
            PG8_WAIT_V(8); PG8_WAIT_L(0); PG8_BAR; PG8_MMA(0, 0, At, B0); PG8_MMA(0, 1, At, B1); PG8_BAR; PG8_SCHED;
            PG8_LDA(At, 1, 1); PG8_STAGE(PG8_SB(1, 0), b3, voffB); PG8_STAGE(PG8_SB(1, 1), b3 + hstep, voffB); PG8_STAGE(PG8_SA(1, 0), a3, voffA);
            PG8_WAIT_V(8); PG8_WAIT_L(0); PG8_BAR; PG8_MMA(1, 0, At, B0); PG8_MMA(1, 1, At, B1); PG8_BAR; PG8_SCHED;
            } else {
            PG8_LDB(B0, 0, 0); PG8_SCHED; PG8_LDA(At, 0, 0); PG8_STAGE(PG8_SA(1, 1), a1 + hstep, voffA);
            PG8_WAIT_L(8); PG8_BAR; PG8_WAIT_L(0); PG8_MMA(0, 0, At, B0); PG8_BAR; PG8_SCHED;
            PG8_LDB(B1, 0, 1); PG8_STAGE(PG8_SB(0, 0), b2, voffB);
            PG8_BAR; PG8_WAIT_L(0); PG8_MMA(0, 1, At, B1); PG8_BAR;
            PG8_LDA(At, 0, 1); PG8_STAGE(PG8_SA(0, 0), a2, voffA);
            PG8_BAR; PG8_WAIT_L(0); PG8_MMA(1, 0, At, B0); PG8_BAR; PG8_SCHED;
            PG8_STAGE(PG8_SB(0, 1), b2 + hstep, voffB);
            PG8_WAIT_V(6); PG8_BAR; PG8_MMA(1, 1, At, B1); PG8_BAR;
            PG8_LDB(B0, 1, 0); PG8_SCHED; PG8_LDA(At, 1, 0); PG8_STAGE(PG8_SA(0, 1), a2 + hstep, voffA);
            PG8_WAIT_L(8); PG8_BAR; PG8_WAIT_L(0); PG8_MMA(0, 0, At, B0); PG8_BAR; PG8_SCHED;
            PG8_LDB(B1, 1, 1); PG8_STAGE(PG8_SB(1, 0), b3, voffB);
            PG8_BAR; PG8_WAIT_L(0); PG8_MMA(0, 1, At, B1); PG8_BAR;
            PG8_LDA(At, 1, 1); PG8_STAGE(PG8_SA(1, 0), a3, voffA);
            PG8_BAR; PG8_WAIT_L(0); PG8_MMA(1, 0, At, B0); PG8_BAR; PG8_SCHED;
            PG8_STAGE(PG8_SB(1, 1), b3 + hstep, voffB);
            PG8_WAIT_V(6); PG8_BAR; PG8_MMA(1, 1, At, B1); PG8_BAR;
            }
        }
        if constexpr (ALIGN_EPI) { if (wr == 0) PG8_BAR; }
        if constexpr (!Epi::AFTER_DRAIN) { E(acc, cur, wr, wc, fr, fq); S.done(cur); }
        if (!has_next) break;
#pragma unroll
        for (int a = 0; a < 2; ++a)
#pragma unroll
            for (int b = 0; b < 2; ++b)
#pragma unroll
                for (int m = 0; m < 4; ++m)
#pragma unroll
                    for (int n = 0; n < 2; ++n) acc[a][b][m][n] = (f32x4){0.f, 0.f, 0.f, 0.f};
        cur = nxt; cA = nA; cB = nB; ++ui;
        if constexpr (ALIGN_EPI) { if (wr == 1) PG8_BAR; }
    }
    PG8_WAIT_V(0);
    if constexpr (!ALIGN_EPI) { if (wr == 0) PG8_BAR; }
    PG8_BAR;
    if constexpr (Epi::AFTER_DRAIN) { E.fused(acc, cur, wr, wc, fr, fq, lds, wid, lane); S.done(cur); }
#undef PG8_SA
#undef PG8_SB
#undef PG8_STAGE
#undef PG8_LDA
#undef PG8_LDB
#undef PG8_MMA
#undef PG8_WAIT_V
#undef PG8_WAIT_L
#undef PG8_BAR
#undef PG8_SCHED
}
}
namespace da {
using pg8::bf16_t;
typedef short bf16x8 __attribute__((ext_vector_type(8)));
typedef short s16x4 __attribute__((ext_vector_type(4)));
typedef float f32x4 __attribute__((ext_vector_type(4)));
typedef unsigned u32x4 __attribute__((ext_vector_type(4)));
#define DA_LAS __attribute__((address_space(3)))
#define DA_SBAR() __builtin_amdgcn_sched_barrier(0)
constexpr int PITCH = 4096;
constexpr int ST_BYTES = 32768;
constexpr int OFF_V = 65536;
constexpr int LDS_SCR = 131072;
constexpr int LDS_NEED = LDS_SCR + 8 * 256;

__device__ __forceinline__ void glds16(const void* gsrc, unsigned lds_dst) { unsigned keep;
    asm volatile("s_mov_b32 %0, m0\n\ts_mov_b32 m0, %2\n\ts_nop 0\n\tglobal_load_lds_dwordx4 %1, off\n\ts_mov_b32 m0, %0" : "=&s"(keep) : "v"(gsrc), "s"(lds_dst) : "memory"); }
template <int OFF> __device__ __forceinline__ s16x4 tr_read(int vb) { s16x4 r; asm volatile("ds_read_b64_tr_b16 %0, %1 offset:%2" : "=&v"(r) : "v"(vb), "i"(OFF) : "memory"); return r; }
template <int OFF> __device__ __forceinline__ bf16x8 k_read(int ad) { bf16x8 r; asm volatile("ds_read_b128 %0, %1 offset:%2" : "=&v"(r) : "v"(ad), "i"(OFF) : "memory"); return r; }

struct Unit {
    const bf16_t* Q; bf16_t* O;
    const bf16_t* K; const bf16_t* V;
    bf16_t* GA; const bf16_t* GB;
    int nt, nt_lo, nt_hi;
    int sample;
};

__device__ __forceinline__ void attn_unit(const Unit& u, DA_LAS unsigned char* lds, float lam, float Mshift, const float* subln) {
    const int tid = threadIdx.x, lane = tid & 63, c16 = lane & 15, g4 = lane >> 4; const int wid = __builtin_amdgcn_readfirstlane(tid >> 6);
    const int g = wid & 3, mp = wid >> 2;
    int my_nt = (g < 2) ? u.nt_lo : u.nt_hi; if (u.sample && g != 0) my_nt = 0;
    const unsigned lds0 = (unsigned)(size_t)lds;
    const bf16_t* src = (wid < 4) ? u.K : u.V;
#define DA_LOFF(p) ((wid < 4) ? (unsigned)((lane_ >> 4) * PITCH + (((lane_ & 15) ^ ((4 * (p) + (lane_ >> 4)) & 15)) * 8)) \
                              : (unsigned)((lane_ >> 5) * PITCH + (((lane_ & 31) ^ (4 * (p) + 2 * (lane_ >> 5))) * 8)))
#define DA_UOFF(i) ((wid < 4) ? (unsigned)((4 * ((wid * 8 + (i)) & 15)) * PITCH + (wid >> 1) * 128) : (unsigned)((16 * (wid - 4) + 2 * (i)) * PITCH))
#define DA_DMA(t, stg) do { int lane_ = lane; asm volatile("" : "+v"(lane_)); const bf16_t* sp_ = src + (size_t)(t) * 64 * PITCH; const unsigned ld_ = lds0 + (unsigned)(stg) * ST_BYTES + (wid < 4 ? (unsigned)wid * 8192u : (unsigned)(OFF_V + (wid - 4) * 8192)); \
        _Pragma("unroll") for (int i_ = 0; i_ < 8; ++i_) glds16(sp_ + (size_t)__builtin_amdgcn_readfirstlane(DA_UOFF(i_)) + DA_LOFF(i_ & 3), (unsigned)__builtin_amdgcn_readfirstlane(ld_ + i_ * 1024)); } while (0)
    DA_DMA(0, 0);
    bf16x8 qr[2][4];
    { const bf16_t* Qw = u.Q + (size_t)((my_nt > 0 ? g * 32 : 0) + c16) * PITCH + mp * 128 + g4 * 8;
#pragma unroll
      for (int qb = 0; qb < 2; ++qb)
#pragma unroll
        for (int ds = 0; ds < 4; ++ds) qr[qb][ds] = *(const bf16x8*)(Qw + (size_t)qb * 16 * PITCH + ds * 32); }
    asm volatile("" : "+v"(qr[0][0]), "+v"(qr[0][1]), "+v"(qr[0][2]), "+v"(qr[0][3]), "+v"(qr[1][0]), "+v"(qr[1][1]), "+v"(qr[1][2]), "+v"(qr[1][3]));
    f32x4 o[2][16];
#pragma unroll
    for (int qb = 0; qb < 2; ++qb)
#pragma unroll
        for (int cb = 0; cb < 16; ++cb) o[qb][cb] = (f32x4){0.f, 0.f, 0.f, 0.f};
    float lq0 = 0.f, lq1 = 0.f;
    const int klane = c16 * 256, vs2 = 4 * (g4 & 1) + (c16 >> 2);
    const int vlane = (4 * g4 + (c16 >> 2)) * 512 + ((c16 >> 1) & 1) * 16 + (c16 & 1) * 8;
    f32x4 negM = (f32x4){-Mshift, -Mshift, -Mshift, -Mshift}; asm volatile("" : "+v"(negM));
    bf16x8 pa[2][2];
#pragma unroll
    for (int s = 0; s < 2; ++s)
#pragma unroll
        for (int qb = 0; qb < 2; ++qb) pa[s][qb] = bf16x8{};
#define DA_W(n) do { asm volatile("s_waitcnt lgkmcnt(" #n ")" ::: "memory"); DA_SBAR(); } while (0)
#define DA_MF(a, b, c) __builtin_amdgcn_mfma_f32_16x16x32_bf16(a, b, c, 0, 0, 0)
#define DA_KRD4(KB, S) do { S##0 = k_read<(KB) * 4096>(kad0); S##1 = k_read<(KB) * 4096>(kad1); S##2 = k_read<(KB) * 4096>(kad2); S##3 = k_read<(KB) * 4096>(kad3); } while (0)
#define DA_QK8(KB, S, FIRST) do { \
        sT[KB][0] = DA_MF(S##0, qr[0][0], sT[KB][0]); sT[KB][1] = DA_MF(S##0, qr[1][0], sT[KB][1]); sT[KB][0] = DA_MF(S##1, qr[0][1], sT[KB][0]); sT[KB][1] = DA_MF(S##1, qr[1][1], sT[KB][1]); \
        sT[KB][0] = DA_MF(S##2, qr[0][2], sT[KB][0]); sT[KB][1] = DA_MF(S##2, qr[1][2], sT[KB][1]); sT[KB][0] = DA_MF(S##3, qr[0][3], sT[KB][0]); sT[KB][1] = DA_MF(S##3, qr[1][3], sT[KB][1]); } while (0)
#define DA_QKP(t) do { \
        const int kb_ = (int)lds0 + ((t) & 1) * 32768 + mp * 16384 + klane; \
        int kad0 = kb_ + (((0 + g4) ^ c16) << 4), kad1 = kb_ + (((4 + g4) ^ c16) << 4), kad2 = kb_ + (((8 + g4) ^ c16) << 4), kad3 = kb_ + (((12 + g4) ^ c16) << 4); \
        asm volatile("" : "+v"(kad0), "+v"(kad1), "+v"(kad2), "+v"(kad3)); \
        bf16x8 ka0, ka1, ka2, ka3, kc0, kc1, kc2, kc3; f32x4 sT[4][2]; \
        _Pragma("unroll") for (int kb = 0; kb < 4; ++kb) { sT[kb][0] = negM; sT[kb][1] = negM; } \
        DA_SBAR(); __builtin_amdgcn_s_setprio(3); DA_KRD4(0, ka); DA_KRD4(1, kc); \
        DA_W(4); DA_QK8(0, ka, true); DA_SBAR(); DA_KRD4(2, ka); \
        DA_W(4); DA_QK8(1, kc, true); DA_SBAR(); DA_KRD4(3, kc); \
        DA_W(4); DA_QK8(2, ka, true); DA_SBAR(); \
        DA_W(0); DA_QK8(3, kc, true); __builtin_amdgcn_s_setprio(0); DA_SBAR(); \
        _Pragma("unroll") for (int kb = 0; kb < 4; ++kb) _Pragma("unroll") for (int qb = 0; qb < 2; ++qb) _Pragma("unroll") for (int r = 0; r < 4; ++r) sT[kb][qb][r] = __builtin_amdgcn_exp2f(sT[kb][qb][r]); \
        if (u.sample && (t) == u.nt - 1) { _Pragma("unroll") for (int kb = 2; kb < 4; ++kb) _Pragma("unroll") for (int qb = 0; qb < 2; ++qb) sT[kb][qb] = (f32x4){0.f, 0.f, 0.f, 0.f}; } \
        _Pragma("unroll") for (int kb = 0; kb < 4; ++kb) { lq0 += (sT[kb][0][0] + sT[kb][0][1]) + (sT[kb][0][2] + sT[kb][0][3]); lq1 += (sT[kb][1][0] + sT[kb][1][1]) + (sT[kb][1][2] + sT[kb][1][3]); } \
        _Pragma("unroll") for (int s = 0; s < 2; ++s) _Pragma("unroll") for (int qb = 0; qb < 2; ++qb) { u32x4 w; \
            w.x = pg8::cvt_pk_bf16(sT[2 * s][qb][0], sT[2 * s][qb][1]); w.y = pg8::cvt_pk_bf16(sT[2 * s][qb][2], sT[2 * s][qb][3]); \
            w.z = pg8::cvt_pk_bf16(sT[2 * s + 1][qb][0], sT[2 * s + 1][qb][1]); w.w = pg8::cvt_pk_bf16(sT[2 * s + 1][qb][2], sT[2 * s + 1][qb][3]); pa[s][qb] = __builtin_bit_cast(bf16x8, w); } } while (0)
#define DA_VRD(CB, S) do { const int a0_ = vad + (((((CB) & 7) ^ vs2)) << 5), a1_ = vad + ((((((CB) + 1) & 7) ^ vs2)) << 5); \
        S##l0 = tr_read<((CB) >> 3) * 256>(a0_); S##h0 = tr_read<((CB) >> 3) * 256 + 8192>(a0_); S##l1 = tr_read<((CB) >> 3) * 256 + 16384>(a0_); S##h1 = tr_read<((CB) >> 3) * 256 + 24576>(a0_); \
        S##l2 = tr_read<((CB) >> 3) * 256>(a1_); S##h2 = tr_read<((CB) >> 3) * 256 + 8192>(a1_); S##l3 = tr_read<((CB) >> 3) * 256 + 16384>(a1_); S##h3 = tr_read<((CB) >> 3) * 256 + 24576>(a1_); } while (0)
#define DA_VPK(L, H) (bf16x8){L[0], L[1], L[2], L[3], H[0], H[1], H[2], H[3]}
#define DA_VMM(CB, S) do { \
        o[0][CB] = DA_MF(pa[0][0], DA_VPK(S##l0, S##h0), o[0][CB]); o[1][CB] = DA_MF(pa[0][1], DA_VPK(S##l0, S##h0), o[1][CB]); \
        o[0][(CB) + 1] = DA_MF(pa[0][0], DA_VPK(S##l2, S##h2), o[0][(CB) + 1]); o[1][(CB) + 1] = DA_MF(pa[0][1], DA_VPK(S##l2, S##h2), o[1][(CB) + 1]); \
        o[0][CB] = DA_MF(pa[1][0], DA_VPK(S##l1, S##h1), o[0][CB]); o[1][CB] = DA_MF(pa[1][1], DA_VPK(S##l1, S##h1), o[1][CB]); \
        o[0][(CB) + 1] = DA_MF(pa[1][0], DA_VPK(S##l3, S##h3), o[0][(CB) + 1]); o[1][(CB) + 1] = DA_MF(pa[1][1], DA_VPK(S##l3, S##h3), o[1][(CB) + 1]); } while (0)
#define DA_PV(tv) do { int vad = (int)lds0 + OFF_V + ((tv) & 1) * 32768 + vlane; asm volatile("" : "+v"(vad)); \
        s16x4 Al0, Ah0, Al1, Ah1, Al2, Ah2, Al3, Ah3, Bl0, Bh0, Bl1, Bh1, Bl2, Bh2, Bl3, Bh3; \
        DA_SBAR(); DA_VRD(0, A); DA_VRD(2, B); DA_W(8); DA_VMM(0, A); DA_SBAR(); \
        DA_VRD(4, A); DA_W(8); DA_VMM(2, B); DA_SBAR(); \
        DA_VRD(6, B); DA_W(8); DA_VMM(4, A); DA_SBAR(); \
        DA_VRD(8, A); DA_W(8); DA_VMM(6, B); DA_SBAR(); \
        DA_VRD(10, B); DA_W(8); DA_VMM(8, A); DA_SBAR(); \
        DA_VRD(12, A); DA_W(8); DA_VMM(10, B); DA_SBAR(); \
        DA_VRD(14, B); DA_W(8); DA_VMM(12, A); DA_SBAR(); \
        DA_W(0); DA_VMM(14, B); DA_SBAR(); } while (0)
#define DA_BAR_V() asm volatile("s_waitcnt vmcnt(0) lgkmcnt(0)\n\ts_barrier" ::: "memory")
#define DA_BAR_L() asm volatile("s_waitcnt lgkmcnt(0)\n\ts_barrier" ::: "memory")
    if (mp == 1) DA_BAR_L();
    for (int t = 0; t < my_nt; ++t) {
        DA_BAR_V();
        if (t + 1 < u.nt) DA_DMA(t + 1, (t + 1) & 1);
        DA_QKP(t);
        DA_BAR_L();
        DA_PV(t);
    }
    for (int t = my_nt; t < u.nt; ++t) {
        DA_BAR_V();
        if (t + 1 < u.nt) DA_DMA(t + 1, (t + 1) & 1);
        DA_BAR_L();
    }
    if (mp == 0) DA_BAR_L();
#undef DA_BAR_V
#undef DA_BAR_L
#undef DA_QKP
#undef DA_QK8
#undef DA_KRD4
#undef DA_PV
#undef DA_VRD
#undef DA_VPK
#undef DA_VMM
#undef DA_DMA
#undef DA_UOFF
#undef DA_LOFF
    lq0 += __shfl_xor(lq0, 16); lq0 += __shfl_xor(lq0, 32); lq1 += __shfl_xor(lq1, 16); lq1 += __shfl_xor(lq1, 32);
    DA_LAS float* wsf = (DA_LAS float*)(lds + LDS_SCR + wid * 256);
    if (g4 == 0) { wsf[c16] = lq0; wsf[16 + c16] = lq1; }
    asm volatile("s_waitcnt lgkmcnt(0)" ::: "memory");
    float rli[2][4];
    const float sc = (mp == 1) ? lam : 1.0f;
#pragma unroll
    for (int qb = 0; qb < 2; ++qb)
#pragma unroll
        for (int r = 0; r < 4; ++r) rli[qb][r] = sc * __builtin_amdgcn_rcpf(wsf[16 * qb + 4 * g4 + r]);
    const size_t goff = (size_t)(g * 32 + 16 * mp + (lane >> 5)) * PITCH + (lane & 31) * 8;
    bf16_t* Ga = u.GA + goff; const bf16_t* Gb = u.GB + goff;
    u32x4 awv[8], swv[8];
#define DA_GLOAD() do { _Pragma("unroll") for (int i = 0; i < 8; ++i) { awv[i] = *(const u32x4*)(Ga + (size_t)i * 2 * PITCH); swv[i] = *(const u32x4*)(Gb + (size_t)i * 2 * PITCH); } } while (0)
    asm volatile("s_waitcnt lgkmcnt(0)\n\ts_barrier" ::: "memory");
    DA_LAS float* Xg = (DA_LAS float*)lds + g * 8192 + lane;
    if (mp == 1 && my_nt > 0) {
#pragma unroll
        for (int qb = 0; qb < 2; ++qb)
#pragma unroll
            for (int cb = 0; cb < 16; ++cb)
#pragma unroll
                for (int r = 0; r < 4; ++r) Xg[((qb * 16 + cb) * 4 + r) * 64] = o[qb][cb][r] * rli[qb][r];
        DA_GLOAD();
    }
    asm volatile("s_waitcnt lgkmcnt(0)\n\ts_barrier" ::: "memory");
    if (mp == 0 && my_nt > 0) {
#pragma unroll
        for (int qb = 0; qb < 2; ++qb)
#pragma unroll
            for (int cb = 0; cb < 16; ++cb)
#pragma unroll
                for (int r = 0; r < 4; ++r) o[qb][cb][r] = o[qb][cb][r] * rli[qb][r] - Xg[((qb * 16 + cb) * 4 + r) * 64];
        asm volatile("s_waitcnt lgkmcnt(0)" ::: "memory");
        DA_LAS bf16_t* stg = (DA_LAS bf16_t*)(lds + g * 32768);
        DA_LAS bf16_t* sw = stg + (4 * g4) * 264 + c16;
#pragma unroll
        for (int qb = 0; qb < 2; ++qb)
#pragma unroll
            for (int cb = 0; cb < 16; ++cb)
#pragma unroll
                for (int r = 0; r < 4; ++r) sw[(16 * qb + r) * 264 + cb * 16] = (bf16_t)(pg8::cvt_pk_bf16(o[qb][cb][r], o[qb][cb][r]) & 0xffffu);
        DA_GLOAD();
    }
    asm volatile("s_waitcnt lgkmcnt(0)\n\ts_barrier" ::: "memory");
    if (my_nt > 0) {
        const DA_LAS bf16_t* stg = (const DA_LAS bf16_t*)(lds + g * 32768);
        float sub[8];
        const pg8::f32x4 sub0 = *(const pg8::f32x4*)(subln + (lane & 31) * 8), sub1 = *(const pg8::f32x4*)(subln + (lane & 31) * 8 + 4);
        sub[0] = sub0[0]; sub[1] = sub0[1]; sub[2] = sub0[2]; sub[3] = sub0[3]; sub[4] = sub1[0]; sub[5] = sub1[1]; sub[6] = sub1[2]; sub[7] = sub1[3];
        const DA_LAS unsigned char* sr = (const DA_LAS unsigned char*)stg + (16 * mp + (lane >> 5)) * 528 + (lane & 31) * 16;
#pragma unroll
        for (int i = 0; i < 8; ++i) { const u32x4 w = *(const DA_LAS u32x4*)(sr + i * 2 * 528);
            const u32x4 aw = awv[i], sw_ = swv[i];
            float f[8], a[8], sg[8];
            f[0] = pg8::bf_lo(w.x); f[1] = pg8::bf_hi(w.x); f[2] = pg8::bf_lo(w.y); f[3] = pg8::bf_hi(w.y); f[4] = pg8::bf_lo(w.z); f[5] = pg8::bf_hi(w.z); f[6] = pg8::bf_lo(w.w); f[7] = pg8::bf_hi(w.w);
            a[0] = pg8::bf_lo(aw.x); a[1] = pg8::bf_hi(aw.x); a[2] = pg8::bf_lo(aw.y); a[3] = pg8::bf_hi(aw.y); a[4] = pg8::bf_lo(aw.z); a[5] = pg8::bf_hi(aw.z); a[6] = pg8::bf_lo(aw.w); a[7] = pg8::bf_hi(aw.w);
            sg[0] = pg8::bf_lo(sw_.x); sg[1] = pg8::bf_hi(sw_.x); sg[2] = pg8::bf_lo(sw_.y); sg[3] = pg8::bf_hi(sw_.y); sg[4] = pg8::bf_lo(sw_.z); sg[5] = pg8::bf_hi(sw_.z); sg[6] = pg8::bf_lo(sw_.w); sg[7] = pg8::bf_hi(sw_.w);
            float ss = 0.f;
#pragma unroll
            for (int e = 0; e < 8; ++e) ss += f[e] * f[e];
            ss += __shfl_xor(ss, 1); ss += __shfl_xor(ss, 2); ss += __shfl_xor(ss, 4); ss += __shfl_xor(ss, 8); ss += __shfl_xor(ss, 16);
            const float rs = __builtin_amdgcn_rsqf(ss * (1.f / 256.f) + 1e-6f) * 0.8f;
#pragma unroll
            for (int e = 0; e < 8; ++e) a[e] = a[e] + sg[e] * (f[e] * rs * sub[e]);
            u32x4 ow; ow.x = pg8::cvt_pk_bf16(a[0], a[1]); ow.y = pg8::cvt_pk_bf16(a[2], a[3]); ow.z = pg8::cvt_pk_bf16(a[4], a[5]); ow.w = pg8::cvt_pk_bf16(a[6], a[7]);
            *(u32x4*)(Ga + (size_t)i * 2 * PITCH) = ow; }
    }
    asm volatile("s_waitcnt lgkmcnt(0)\n\ts_barrier" ::: "memory");
#undef DA_GLOAD
#undef DA_W
#undef DA_MF
}
}

constexpr int NWAVES = 8;
#ifndef MK_N_LAUNCHES
#define MK_N_LAUNCHES 1
#endif
constexpr int N_LAUNCHES = MK_N_LAUNCHES;
constexpr int P1_CONV_WGS = 7, P5_CONV_WGS = 48;
constexpr int P7_SPLITS = 8;
constexpr int P7_WGM = 2;
constexpr int P1_WGM = 4;
constexpr int N_PHASES = 8;
static_assert(N_LAUNCHES == 1, "this build is the one-launch kernel (the split-K reduce after P7 needs the in-kernel grid barrier)");

constexpr int DM = 4096, SEQ = 8192, MP = 2 * SEQ, DEC_B = 8, DEC_T = 32, MS = DEC_B * DEC_T, M = MP + MS, PAST = 1024, SKROWS = 1088;
constexpr int POOL_IN = 2048, PG_IN = 512, PG_OUT = 1024, DFF = 11008, IN_COLS = 22528;
constexpr float EPS = 1e-6f;
constexpr float QSCALE = 0.08838834764831845f * 1.4426950408889634f;
constexpr float MBOUND = 11.313708498984761f * 1.4426950408889634f;
constexpr size_t OFF_Y = 0, OFF_NPP = 68157440, OFF_NKP = 68218880, OFF_NVP = 135327744, OFF_NPS = 202436608, OFF_NKS = 202682368, OFF_NVS = 203730944, OUT_SIZE = 204779520;

constexpr size_t MiB = 1u << 20;
constexpr size_t WS_CTL = 0, CTL_ZERO_BYTES = 1 * MiB;
constexpr size_t WS_WIN = 2 * MiB;
constexpr size_t WS_H = 178 * MiB;
constexpr size_t WS_SK = 308 * MiB, WS_SV = 376 * MiB;
constexpr size_t WS_WPOOL = 444 * MiB;
constexpr size_t WS_WOUT = 448 * MiB;
constexpr size_t WS_WFO = 480 * MiB;
constexpr size_t WS_POOLED = 566 * MiB;
constexpr size_t WS_U = 631 * MiB;
constexpr size_t WS_Q = 696 * MiB, WS_K = 826 * MiB, WS_V = 956 * MiB, WS_GA = 1086 * MiB, WS_GB = 1216 * MiB;
constexpr size_t WS_HFF = WS_Q;
constexpr size_t WS_PART = 1346 * MiB;
constexpr size_t WS_END = 1378 * MiB;
static_assert(WS_HFF + (size_t)M * DFF * 2 <= WS_GA, "Hff overlay");
constexpr int CW_TMO = 0, CW_CODE = 1;
constexpr int CW_BAR = 4096;
constexpr int CW_ROWSS = 16384;
static_assert((CW_ROWSS + M) * 4 <= (int)CTL_ZERO_BYTES, "CTL words inside the memset region");

constexpr int RING_OFF = 0, RING_BYTES = 131072;
constexpr int ATT_SCR_OFF = RING_BYTES;
constexpr int XS_OFF = RING_BYTES + 2048;
constexpr int LDSCTL_OFF = XS_OFF + 8192, MISC_OFF = LDSCTL_OFF + 320;
constexpr int LDS_BYTES = 147456;
static_assert(MISC_OFF + 128 <= LDS_BYTES && da::LDS_NEED <= LDSCTL_OFF, "LDS map");

#define GAS __attribute__((address_space(1)))
#define LAS __attribute__((address_space(3)))
typedef unsigned short bf16;
typedef unsigned v4u __attribute__((ext_vector_type(4)));
typedef float f32x4 __attribute__((ext_vector_type(4)));
typedef short bf16x8 __attribute__((ext_vector_type(8)));
typedef GAS unsigned gu32;
typedef GAS unsigned long long gu64;
#define RLX_AGENT __ATOMIC_RELAXED, __HIP_MEMORY_SCOPE_AGENT
#define LDS_WAIT() asm volatile("s_waitcnt lgkmcnt(0)" ::: "memory")
#define VM_WAIT() asm volatile("s_waitcnt vmcnt(0)" ::: "memory")
__device__ __forceinline__ unsigned long long rt() { return __builtin_amdgcn_s_memrealtime(); }
__device__ __forceinline__ unsigned f2bf(float f) { unsigned u = __builtin_bit_cast(unsigned, f); return (u + 0x7fffu + ((u >> 16) & 1u)) >> 16; }
__device__ __forceinline__ unsigned pk2(float lo, float hi) { return f2bf(lo) | (f2bf(hi) << 16); }

#define XB_TMO      128
#define XB_XCNT(j)  (256  + 64 * (j))
#define XB_XSUB(j)  (1280 + 64 * (j))
#define XB_XGEN(j)  (2304 + 64 * (j))
#define XB_TOP      3328
#define XB_TOPGEN   3392
#define XCD_BAR_WORDS 3456
#define XB_SPIN_CAP (1u << 18)

__device__ __forceinline__ unsigned xb_ld(unsigned* p)              { return __hip_atomic_load(p, __ATOMIC_RELAXED, __HIP_MEMORY_SCOPE_AGENT); }
__device__ __forceinline__ unsigned xb_add(unsigned* p, unsigned v) { return __hip_atomic_fetch_add(p, v, __ATOMIC_RELAXED, __HIP_MEMORY_SCOPE_AGENT); }
__device__ __forceinline__ unsigned xb_xcc_id() { return (unsigned)__builtin_amdgcn_s_getreg((3 << 11) | 20) & 0xFu; }
#define XB_SPIN(cond, bar) do { unsigned _sp = 0; while (cond) { __builtin_amdgcn_s_sleep(1); \
    if ((++_sp & 255u) == 0u) { if (xb_ld(&(bar)[XB_TMO])) break; if (_sp > XB_SPIN_CAP) { atomicAdd(&(bar)[XB_TMO], 1u); break; } } } } while (0)

struct XcdBarrier {
    unsigned* bar; unsigned x;
    volatile LAS unsigned* st;
};

__device__ __forceinline__ XcdBarrier xcd_barrier_post(unsigned* bar, volatile LAS unsigned* st) {
    XcdBarrier b; b.bar = bar; b.x = xb_xcc_id(); b.st = st;
    if (threadIdx.x == 0) (void)xb_add(&bar[XB_XCNT(b.x)], 1u);
    return b;
}
__device__ __forceinline__ void xcd_barrier_complete(unsigned* bar, unsigned x, unsigned& nloc, unsigned& nx) {
    const unsigned G = gridDim.x * gridDim.y * gridDim.z;
    unsigned sum, cnt, mine, sp = 0u;
    for (;;) {
        sum = 0u; cnt = 0u; mine = 0u;
#pragma unroll
        for (unsigned j = 0; j < 16; ++j) { const unsigned c = xb_ld(&bar[XB_XCNT(j)]); sum += c; cnt += (c > 0u) ? 1u : 0u; mine = (j == x) ? c : mine; }
        if (sum == G) break;
        __builtin_amdgcn_s_sleep(1);
        if ((++sp & 255u) == 0u) { if (xb_ld(&bar[XB_TMO])) break; if (sp > XB_SPIN_CAP) { atomicAdd(&bar[XB_TMO], 1u); break; } }
    }
    nloc = mine > 0u ? mine : 1u; nx = cnt > 0u ? cnt : 1u;
}

__device__ __forceinline__ void xcd_barrier(const XcdBarrier& b) {
    asm volatile("s_waitcnt vmcnt(0)" ::: "memory");
    __syncthreads();
    if (threadIdx.x == 0) {
        unsigned* bar = b.bar;
        __builtin_amdgcn_s_waitcnt(0);
        unsigned nloc = b.st[0], nx = b.st[1];
        if (nloc == 0u) { xcd_barrier_complete(bar, b.x, nloc, nx); b.st[0] = nloc; b.st[1] = nx; }
        const unsigned old = xb_add(&bar[XB_XSUB(b.x)], 1u);
        const unsigned gen = old / nloc;
        if (old + 1u == (gen + 1u) * nloc) {
            __builtin_amdgcn_fence(__ATOMIC_RELEASE, "agent");
            asm volatile("s_waitcnt vmcnt(0)" ::: "memory");
            const unsigned og = xb_add(&bar[XB_TOP], 1u);
            const unsigned tg = og / nx;
            if (og + 1u == (tg + 1u) * nx) xb_add(&bar[XB_TOPGEN], 1u);
            else XB_SPIN(xb_ld(&bar[XB_TOPGEN]) == tg, bar);
            __builtin_amdgcn_fence(__ATOMIC_ACQUIRE, "agent");
            xb_add(&bar[XB_XGEN(b.x)], 1u);
            asm volatile("s_waitcnt vmcnt(0)" ::: "memory");
        } else {
            XB_SPIN(xb_ld(&bar[XB_XGEN(b.x)]) == gen, bar);
            __builtin_amdgcn_fence(__ATOMIC_ACQUIRE, "agent");
            asm volatile("s_waitcnt vmcnt(0)" ::: "memory");
        }
    }
    __syncthreads();
}

struct Frame {
    LAS unsigned char* lds;
    volatile LAS unsigned* MISC;
    gu32* ctl;
    int tid, lane, wave;
    int vcu, G;
    const float* in[20]; float* out; unsigned char* ws;
};
enum { I_XP = 0, I_XS, I_CPOOL, I_CK, I_CV, I_NMIX, I_WIN, I_WPOOL, I_PSCALE, I_QN, I_KN, I_LQ1, I_LK1, I_LQ2, I_LK2, I_SUBLN, I_WOUT, I_NFFN, I_WFI, I_WFO };

__device__ __forceinline__ float wave_sum(float v) {
#pragma unroll
    for (int o = 1; o < 64; o <<= 1) v += __shfl_xor(v, o);
    return v;
}
__device__ __forceinline__ float wave_max(float v) {
#pragma unroll
    for (int o = 1; o < 64; o <<= 1) v = fmaxf(v, __shfl_xor(v, o));
    return v;
}
__device__ __forceinline__ void unpack8(const v4u w, float (&f)[8]) {
    f[0] = pg8::bf_lo(w.x); f[1] = pg8::bf_hi(w.x); f[2] = pg8::bf_lo(w.y); f[3] = pg8::bf_hi(w.y);
    f[4] = pg8::bf_lo(w.z); f[5] = pg8::bf_hi(w.z); f[6] = pg8::bf_lo(w.w); f[7] = pg8::bf_hi(w.w);
}
__device__ __forceinline__ v4u pack8f(const float (&f)[8]) {
    v4u o; o.x = pg8::cvt_pk_bf16(f[0], f[1]); o.y = pg8::cvt_pk_bf16(f[2], f[3]); o.z = pg8::cvt_pk_bf16(f[4], f[5]); o.w = pg8::cvt_pk_bf16(f[6], f[7]); return o;
}

__device__ __forceinline__ void transpose_load(const float* W, int N, int k0, int n0, int lane, f32x4 (&v)[8]) {
    const GAS float* p = (const GAS float*)W + (size_t)(k0 + 8 * (lane & 7)) * N + n0 + 4 * (lane >> 3);
#pragma unroll
    for (int e = 0; e < 8; ++e) v[e] = *(const GAS f32x4*)(p + (size_t)e * N);
}
__device__ __forceinline__ void transpose_store(bf16* WT, int Kd, size_t dst_row0, int k0, int lane, const f32x4 (&v)[8]) {
    GAS bf16* q = (GAS bf16*)WT + (dst_row0 + 4 * (lane >> 3)) * Kd + k0 + 8 * (lane & 7);
#pragma unroll
    for (int i = 0; i < 4; ++i) { v4u o; o.x = pg8::cvt_pk_bf16(v[0][i], v[1][i]); o.y = pg8::cvt_pk_bf16(v[2][i], v[3][i]); o.z = pg8::cvt_pk_bf16(v[4][i], v[5][i]); o.w = pg8::cvt_pk_bf16(v[6][i], v[7][i]);
        *(GAS v4u*)(q + (size_t)i * Kd) = o; }
}
__device__ __forceinline__ void transpose_item(const float* W, int N, bf16* WT, int Kd, size_t dst_row0, int k0, int n0, LAS float* scr, int lane) {
    (void)scr; f32x4 v[8]; transpose_load(W, N, k0, n0, lane, v); transpose_store(WT, Kd, dst_row0, k0, lane, v);
}

template <int MODE> __device__ __forceinline__ size_t transpose_drow(int n0) {
    if (MODE == 0) return (size_t)n0;
    const int up = n0 >= DFF, nn = up ? n0 - DFF : n0; return (size_t)256 * (nn / 128) + (up ? 128 : 0) + (nn % 128);
}
template <int MODE> __device__ __forceinline__ void transpose_range(const float* W, int N, bf16* WT, int Kd, int NB, int NIT, int w, int nw, int lane) {
    for (int it = w; it < NIT; it += 2 * nw) {
        const int it2 = it + nw; const bool has2 = it2 < NIT;
        const int kb = it / NB, nb = it % NB, kb2 = has2 ? it2 / NB : kb, nb2 = has2 ? it2 % NB : nb;
        f32x4 va[8], vb[8];
        transpose_load(W, N, kb * 64, nb * 32, lane, va);
        if (has2) transpose_load(W, N, kb2 * 64, nb2 * 32, lane, vb);
        transpose_store(WT, Kd, transpose_drow<MODE>(nb * 32), kb * 64, lane, va);
        if (has2) transpose_store(WT, Kd, transpose_drow<MODE>(nb2 * 32), kb2 * 64, lane, vb);
    }
}

__device__ __forceinline__ void rms_row_to_bf16(const float* xrow, const float* g, bf16* orow, int lane) {
    const GAS f32x4* xr = (const GAS f32x4*)xrow + lane; const GAS f32x4* gr = (const GAS f32x4*)g + lane;
    f32x4 v[16]; float s = 0.f;
#pragma unroll
    for (int j = 0; j < 16; ++j) { v[j] = xr[64 * j]; s += (v[j].x * v[j].x + v[j].y * v[j].y) + (v[j].z * v[j].z + v[j].w * v[j].w); }
    const float rs = __builtin_amdgcn_rsqf(wave_sum(s) * (1.f / DM) + EPS);
    GAS unsigned long long* o8 = (GAS unsigned long long*)orow + lane;
#pragma unroll
    for (int j = 0; j < 16; ++j) { const f32x4 gg = gr[64 * j];
        o8[64 * j] = (unsigned long long)pg8::cvt_pk_bf16(v[j].x * rs * gg.x, v[j].y * rs * gg.y) | ((unsigned long long)pg8::cvt_pk_bf16(v[j].z * rs * gg.z, v[j].w * rs * gg.w) << 32); }
}

__device__ __forceinline__ void p0_prologue(Frame& F) {
    LAS float* scr = (LAS float*)(F.lds + RING_OFF + F.wave * 16384);
    const int gw = F.vcu * NWAVES + F.wave, NGW = F.G * NWAVES;
    unsigned char* ws = F.ws;
    constexpr int NB_IN = IN_COLS / 32, I_IN = (DM / 64) * NB_IN;
    constexpr int NB_P = PG_OUT / 32, I_P1 = (PG_IN / 64) * NB_P, I_P = 4 * I_P1;
    transpose_range<0>(F.in[I_WIN], IN_COLS, (bf16*)(ws + WS_WIN), DM, NB_IN, I_IN, gw, NGW, F.lane);
    { constexpr int NB_O = DM / 32, I_O = (DM / 64) * NB_O;
      transpose_range<0>(F.in[I_WOUT], DM, (bf16*)(ws + WS_WOUT), DM, NB_O, I_O, gw, NGW, F.lane); }
    { constexpr int NB_O = DM / 32, I_FO = (DFF / 64) * NB_O;
      transpose_range<0>(F.in[I_WFO], DM, (bf16*)(ws + WS_WFO), DFF, NB_O, I_FO, gw, NGW, F.lane); }
    for (int r = gw; r < I_P; r += NGW) { const int gI = r / I_P1, q = r % I_P1, kb = q / NB_P, nb = q % NB_P;
        transpose_item(F.in[I_WPOOL] + (size_t)gI * PG_IN * PG_OUT, PG_OUT, (bf16*)(ws + WS_WPOOL) + (size_t)gI * PG_OUT * PG_IN, PG_IN, (size_t)nb * 32, kb * 64, nb * 32, scr, F.lane); }
    for (int m = gw; m < M; m += NGW) {
        const float* xrow = (m < MP) ? F.in[I_XP] + (size_t)m * DM : F.in[I_XS] + (size_t)(m - MP) * DM;
        rms_row_to_bf16(xrow, F.in[I_NMIX], (bf16*)(ws + WS_H) + (size_t)m * DM, F.lane);
    }
}
__device__ __forceinline__ void conv_p1(Frame& F, int w, int nw) {
    LAS float* scr = (LAS float*)(F.lds + RING_OFF + F.wave * 16384);
    unsigned char* ws = F.ws;
    constexpr int CROWS = DEC_B * PAST;
    for (int r = w; r < 2 * CROWS + 2 * DEC_B * 32; r += nw) {
        if (r < 2 * CROWS) { const int isv = r >= CROWS, rr = isv ? r - CROWS : r, b = rr / PAST, s = rr % PAST;
            const GAS f32x4* src = (const GAS f32x4*)((isv ? F.in[I_CV] : F.in[I_CK]) + (size_t)rr * DM);
            GAS v4u* dst = (GAS v4u*)((bf16*)(ws + (isv ? WS_SV : WS_SK)) + (size_t)(b * SKROWS + s) * DM);
#pragma unroll
            for (int j = 0; j < 8; ++j) { const int ch = j * 64 + F.lane; const f32x4 a = src[2 * ch], c = src[2 * ch + 1];
                v4u o; o.x = pg8::cvt_pk_bf16(a.x, a.y); o.y = pg8::cvt_pk_bf16(a.z, a.w); o.z = pg8::cvt_pk_bf16(c.x, c.y); o.w = pg8::cvt_pk_bf16(c.z, c.w); dst[ch] = o; }
        } else { const int q = r - 2 * CROWS, isv = q >= DEC_B * 32, qq = isv ? q - DEC_B * 32 : q, b = qq / 32, s = PAST + DEC_T + qq % 32;
            GAS v4u* dst = (GAS v4u*)((bf16*)(ws + (isv ? WS_SV : WS_SK)) + (size_t)(b * SKROWS + s) * DM);
#pragma unroll
            for (int j = 0; j < 8; ++j) dst[j * 64 + F.lane] = (v4u){0u, 0u, 0u, 0u}; }
    }
}
__device__ __forceinline__ void conv_p5(Frame& F, int w, int nw) {
    LAS float* scr = (LAS float*)(F.lds + RING_OFF + F.wave * 16384);
    constexpr int NB = (2 * DFF) / 32, NIT = (DM / 64) * NB;
    transpose_range<1>(F.in[I_WFI], 2 * DFF, (bf16*)(F.ws + WS_WIN), DM, NB, NIT, w, nw, F.lane);
}

template <int G_> __device__ __forceinline__ void p2_pool_batch(Frame& F, int row0, bool samp, int b, int t0) {
    constexpr int W = 2 << G_, NB = 8, NR = NB + W - 1;
    unsigned char* ws = F.ws; const int lane = F.lane; const int c0 = G_ * PG_IN + lane * 8;
    const bf16* U = (const bf16*)(ws + WS_U);
    v4u rw[NR];
#pragma unroll
    for (int a = 0; a < NR; ++a) { const int tt = t0 - (W - 1) + a;
        if (tt >= 0) rw[a] = *(const GAS v4u*)(U + (size_t)(row0 - (W - 1) + a) * POOL_IN + c0);
        else if (samp) { const GAS f32x4* cp = (const GAS f32x4*)(F.in[I_CPOOL] + ((size_t)b * 15 + (15 + tt)) * POOL_IN + c0); const f32x4 x0 = cp[0], x1 = cp[1];
            v4u o; o.x = pg8::cvt_pk_bf16(x0.x, x0.y); o.y = pg8::cvt_pk_bf16(x0.z, x0.w); o.z = pg8::cvt_pk_bf16(x1.x, x1.y); o.w = pg8::cvt_pk_bf16(x1.z, x1.w); rw[a] = o; }
        else rw[a] = (v4u){0u, 0u, 0u, 0u}; }
    float S[8];
#pragma unroll
    for (int e = 0; e < 8; ++e) S[e] = 0.f;
#pragma unroll
    for (int a = 0; a < W; ++a) { float f[8]; unpack8(rw[a], f);
#pragma unroll
        for (int e = 0; e < 8; ++e) S[e] += f[e]; }
#pragma unroll
    for (int i = 0; i < NB; ++i) { const int t = t0 + i, row = row0 + i;
        float cur[8]; unpack8(rw[i + W - 1], cur);
        const int cnt = samp ? W : ((t + 1 < W) ? t + 1 : W);
        const float inv = 1.0f / (float)cnt;
        float p[8];
#pragma unroll
        for (int e = 0; e < 8; ++e) p[e] = S[e] * inv - cur[e];
        *(GAS v4u*)((bf16*)(ws + WS_POOLED) + ((size_t)G_ * M + row) * PG_IN + lane * 8) = pack8f(p);
        float* np = nullptr;
        if (!samp && t >= SEQ - 15) np = F.out + OFF_NPP + ((size_t)b * 15 + (t - (SEQ - 15))) * POOL_IN + c0;
        if (samp && t >= DEC_T - 15) np = F.out + OFF_NPS + ((size_t)b * 15 + (t - (DEC_T - 15))) * POOL_IN + c0;
        if (np) { *(GAS f32x4*)np = (f32x4){cur[0], cur[1], cur[2], cur[3]}; *(GAS f32x4*)(np + 4) = (f32x4){cur[4], cur[5], cur[6], cur[7]}; }
        if (i < NB - 1) { float fn[8], fo[8]; unpack8(rw[i + W], fn); unpack8(rw[i], fo);
#pragma unroll
            for (int e = 0; e < 8; ++e) S[e] += fn[e] - fo[e]; } }
}
__device__ __forceinline__ void pool_quad(Frame& F, int quad) {
    const int pm = quad >> 2, gI = quad & 3;
    for (int j = F.wave; j < 32; j += NWAVES) { const int row0 = pm * 256 + 8 * j; const bool samp = row0 >= MP;
        const int b = samp ? (row0 - MP) / DEC_T : row0 / SEQ, t0 = samp ? (row0 - MP) % DEC_T : row0 % SEQ;
        if (gI == 0) p2_pool_batch<0>(F, row0, samp, b, t0); else if (gI == 1) p2_pool_batch<1>(F, row0, samp, b, t0);
        else if (gI == 2) p2_pool_batch<2>(F, row0, samp, b, t0); else p2_pool_batch<3>(F, row0, samp, b, t0); }
}

__device__ __forceinline__ void p4_attention(Frame& F) {
    unsigned char* ws = F.ws;
    float lam, Mshift;
    { const int l2 = F.lane * 2;
      const float s1 = wave_sum(F.in[I_LQ1][l2] * F.in[I_LK1][l2] + F.in[I_LQ1][l2 + 1] * F.in[I_LK1][l2 + 1]);
      const float s2 = wave_sum(F.in[I_LQ2][l2] * F.in[I_LK2][l2] + F.in[I_LQ2][l2 + 1] * F.in[I_LK2][l2 + 1]);
      lam = __expf(s1) - __expf(s2) + 0.2f;
      const float gq = wave_max(fmaxf(fabsf(F.in[I_QN][l2]), fabsf(F.in[I_QN][l2 + 1]))), gk = wave_max(fmaxf(fabsf(F.in[I_KN][l2]), fabsf(F.in[I_KN][l2 + 1])));
      Mshift = MBOUND * gq * gk;
      lam = __uint_as_float(__builtin_amdgcn_readfirstlane(__float_as_uint(lam))); Mshift = __uint_as_float(__builtin_amdgcn_readfirstlane(__float_as_uint(Mshift))); }
    const bf16* Qb = (const bf16*)(ws + WS_Q); const bf16* Kb = (const bf16*)(ws + WS_K); const bf16* Vb = (const bf16*)(ws + WS_V);
    const bf16* SKb = (const bf16*)(ws + WS_SK); const bf16* SVb = (const bf16*)(ws + WS_SV);
    bf16* GAb = (bf16*)(ws + WS_GA); const bf16* GBb = (const bf16*)(ws + WS_GB);
    for (int v = F.vcu; v < 256; v += F.G) {
        const int xcd = v >> 5, j = v & 31;
        for (int idx = 0; idx < 9; ++idx) {
            da::Unit u;
            if (idx < 8) { const int bh = xcd * 4 + (idx >> 1), b = bh >> 4, h = bh & 15, k2 = 2 * (j >> 1), uq = (j & 1) ? ((idx & 1) ? k2 + 1 : 63 - k2) : ((idx & 1) ? k2 : 62 - k2);
                u.Q = Qb + ((size_t)b * SEQ + (size_t)uq * 128) * DM + h * 256; u.O = (bf16*)u.Q; u.GA = GAb + (u.Q - Qb); u.GB = GBb + (u.Q - Qb);
                u.K = Kb + (size_t)b * SEQ * DM + h * 256; u.V = Vb + (size_t)b * SEQ * DM + h * 256;
                u.nt = 2 * uq + 2; u.nt_lo = 2 * uq + 1; u.nt_hi = 2 * uq + 2; u.sample = 0; }
            else { if (v & 1) break; const int si = v >> 1, b = si >> 4, h = si & 15;
                u.Q = Qb + ((size_t)MP + (size_t)b * DEC_T) * DM + h * 256; u.O = (bf16*)u.Q; u.GA = GAb + (u.Q - Qb); u.GB = GBb + (u.Q - Qb);
                u.K = SKb + (size_t)b * SKROWS * DM + h * 256; u.V = SVb + (size_t)b * SKROWS * DM + h * 256;
                u.nt = 17; u.nt_lo = 17; u.nt_hi = 17; u.sample = 1; }
            da::attn_unit(u, F.lds + RING_OFF, lam, Mshift, F.in[I_SUBLN]);
        }
    }
}

struct Args { const float* in[20]; float* out; unsigned char* ws; int ph_lo, ph_hi, li, pad; };
__global__ void __launch_bounds__(NWAVES * 64, 2) mk_fwd(Args args) {
    extern __shared__ __attribute__((aligned(16))) unsigned char lds[];
    Frame F;
    F.lds = (LAS unsigned char*)lds;
    F.MISC = (volatile LAS unsigned*)(F.lds + MISC_OFF);
    F.tid = threadIdx.x; F.lane = F.tid & 63; F.wave = __builtin_amdgcn_readfirstlane(F.tid >> 6);
    F.G = gridDim.x; { const int bx = blockIdx.x; F.vcu = (F.G % 8 == 0) ? (bx % 8) * (F.G / 8) + bx / 8 : bx; }
#pragma unroll
    for (int i = 0; i < 20; ++i) F.in[i] = args.in[i];
    F.out = args.out; F.ws = args.ws;
    unsigned char* ws = args.ws;
    F.ctl = (gu32*)(ws + WS_CTL);
    for (int u = F.tid; u < (LDS_BYTES - LDSCTL_OFF) / 4; u += NWAVES * 64) ((LAS unsigned*)(F.lds + LDSCTL_OFF))[u] = 0u;
    __syncthreads();
    XcdBarrier bar; bar.bar = (unsigned*)(F.ctl + CW_BAR); bar.x = 0; bar.st = nullptr;
    if (N_LAUNCHES == 1) bar = xcd_barrier_post((unsigned*)(F.ctl + CW_BAR), F.MISC + 8);
#define GRID_BAR(seam) do { if (N_LAUNCHES != 1) { if (F.tid == 0) __hip_atomic_store(F.ctl + CW_TMO, 0xBADBA0u | (unsigned)(seam), RLX_AGENT); } else { xcd_barrier(bar); } } while (0)
    const int lo = args.ph_lo, hi = args.ph_hi;
#ifndef PH_MASK
#define PH_MASK 0xff
#endif
#define IN(k) (((PH_MASK >> (k)) & 1) && lo <= (k) && (k) < hi)
#define BOTH(k) (IN(k) && IN((k) + 1))
    bf16* const Wt_in = (bf16*)(ws + WS_WIN); bf16* const Hb = (bf16*)(ws + WS_H);
    float* const rowss = (float*)(ws + WS_CTL) + CW_ROWSS;

    if (IN(0)) {
        p0_prologue(F); if (BOTH(0)) GRID_BAR(0); }

    if (IN(1)) {
        const int nabs = pg8::AbsOrder::fit((M / 256) * (IN_COLS / 256), F.G, P1_CONV_WGS);
        if (nabs == 0) { conv_p1(F, F.vcu * NWAVES + F.wave, F.G * NWAVES); __syncthreads(); }
        else if ((int)blockIdx.x >= F.G - nabs) conv_p1(F, ((int)blockIdx.x - (F.G - nabs)) * NWAVES + F.wave, nabs * NWAVES);
        pg8::Gemm g{Hb, Wt_in, M, IN_COLS, DM, 0, 0}; pg8::AbsOrder S; S.init(M, IN_COLS, F.G, (int)blockIdx.x, nabs, P1_WGM);
        pg8::EpiInProj E{(bf16*)(ws + WS_U), (bf16*)(ws + WS_Q), (bf16*)(ws + WS_K), (bf16*)(ws + WS_V), (bf16*)(ws + WS_GA), (bf16*)(ws + WS_GB), (bf16*)(ws + WS_SK), (bf16*)(ws + WS_SV),
                            F.out + OFF_NVP, F.out + OFF_NVS, F.out + OFF_NKP, F.out + OFF_NKS, F.in[I_QN], F.in[I_KN], (LAS float*)(F.lds + XS_OFF), QSCALE};
        pg8::gemm_phase<pg8::EpiInProj, pg8::AbsOrder, true, true>(F.lds + RING_OFF, g, S, E);
        if (BOTH(1)) GRID_BAR(1);
    }

    if (IN(3)) {
        pg8::QuadOrder S; S.init(M, F.G, F.vcu);
        for (int j = 0; j < S.nown; ++j) pool_quad(F, S.c + j * S.G);
        if (S.has_left()) pool_quad(F, S.left_quad());
        asm volatile("s_waitcnt vmcnt(0)" ::: "memory"); __syncthreads();
        pg8::Gemm g{(bf16*)(ws + WS_POOLED), (bf16*)(ws + WS_WPOOL), M, 4 * PG_OUT, PG_IN, (size_t)M * PG_IN * 2, 4};
        pg8::EpiPool E{(bf16*)(ws + WS_GA), F.in[I_PSCALE]};
        pg8::gemm_phase<pg8::EpiPool, pg8::QuadOrder, true, true>(F.lds + RING_OFF, g, S, E);
        if (BOTH(3)) GRID_BAR(3);
    }

    if (IN(4)) { p4_attention(F); if (BOTH(4)) GRID_BAR(4); }

    if (IN(5)) {
        const int nabs = pg8::AbsOrder::fit((M / 256) * (DM / 256), F.G, P5_CONV_WGS);
        if (nabs == 0) { conv_p5(F, F.vcu * NWAVES + F.wave, F.G * NWAVES); __syncthreads(); }
        else if ((int)blockIdx.x >= F.G - nabs) conv_p5(F, ((int)blockIdx.x - (F.G - nabs)) * NWAVES + F.wave, nabs * NWAVES);
        pg8::Gemm g{(bf16*)(ws + WS_GA), (bf16*)(ws + WS_WOUT), M, DM, DM, 0, 0}; pg8::AbsOrder S; S.init(M, DM, F.G, (int)blockIdx.x, nabs);
        pg8::EpiWout E{F.in[I_XP], F.in[I_XS], F.out + OFF_Y, Hb, F.in[I_NFFN], rowss};
        pg8::gemm_phase<pg8::EpiWout, pg8::AbsOrder, true, true>(F.lds + RING_OFF, g, S, E);
        if (BOTH(5)) GRID_BAR(5);
    }

    if (IN(6)) {
        pg8::Gemm g{Hb, Wt_in, M, 2 * DFF, DM, 0, 0}; pg8::StaticOrder S; S.init(M, 2 * DFF, F.G, (int)blockIdx.x, P1_WGM);
        pg8::EpiSwiGLU E{(bf16*)(ws + WS_HFF), rowss};
        pg8::gemm_phase<pg8::EpiSwiGLU, pg8::StaticOrder, true, true>(F.lds + RING_OFF, g, S, E);
        if (BOTH(6)) GRID_BAR(6);
    }

    if (IN(7)) {
        pg8::Gemm g{(bf16*)(ws + WS_HFF), (bf16*)(ws + WS_WFO), M, DM, DFF, 0, 0}; pg8::SplitOrder S; S.init(MP, DM, DFF, F.G, (int)blockIdx.x, P7_SPLITS, P7_WGM);
        pg8::EpiFfnOut E{F.out + OFF_Y, (float*)(ws + WS_PART)};
        pg8::gemm_phase<pg8::EpiFfnOut, pg8::SplitOrder, true, true>(F.lds + RING_OFF, g, S, E);
        if (IN(7) && N_LAUNCHES == 1) { GRID_BAR(7);
            const int gw = F.vcu * NWAVES + F.wave, NGW = F.G * NWAVES;
            for (int r = gw; r < MS; r += NGW) { GAS f32x4* yr = (GAS f32x4*)(F.out + OFF_Y + (size_t)(MP + r) * DM) + F.lane;
#pragma unroll 1
                for (int j = 0; j < 16; ++j) { f32x4 a = yr[64 * j];
#pragma unroll
                    for (int s = 0; s < P7_SPLITS; ++s) a += ((const GAS f32x4*)((const float*)(ws + WS_PART) + ((size_t)s * 256 + r) * DM) + F.lane)[64 * j];
                    yr[64 * j] = a; } } }
    }
#undef IN
#undef BOTH
#undef GRID_BAR
}

extern "C" void kernel_launch(void* const* d_in, const int* in_sizes, int n_in, void* d_out, int out_size, void* d_ws, size_t ws_size, hipStream_t stream) {
    static int grid = 0;
    if (grid == 0) {
        if (n_in != 20 || in_sizes[0] != MP * DM || (size_t)out_size != OUT_SIZE || ws_size < WS_END) {
            fprintf(stderr, "kernel_launch: shape mismatch: n_in %d in0 %d out %d ws %zu (need >= %zu); nothing launched\n", n_in, n_in > 0 ? in_sizes[0] : -1, out_size, ws_size, (size_t)WS_END); grid = -1; return; }
        int dev = 0, cus = 0, per_cu = 0;
        if (hipGetDevice(&dev) != hipSuccess || hipDeviceGetAttribute(&cus, hipDeviceAttributeMultiprocessorCount, dev) != hipSuccess) { fprintf(stderr, "kernel_launch: device query failed\n"); grid = -1; return; }
        if (hipFuncSetAttribute((const void*)mk_fwd, hipFuncAttributeMaxDynamicSharedMemorySize, LDS_BYTES) != hipSuccess) { fprintf(stderr, "kernel_launch: hipFuncSetAttribute failed\n"); grid = -1; return; }
        if (hipOccupancyMaxActiveBlocksPerMultiprocessor(&per_cu, (const void*)mk_fwd, NWAVES * 64, LDS_BYTES) != hipSuccess || per_cu < 1)
            fprintf(stderr, "kernel_launch: note: occupancy query reports %d workgroups per CU\n", per_cu);
        (void)hipGetLastError();
        grid = cus;
    }
    if (grid < 0) return;
    if (hipMemsetAsync((char*)d_ws + WS_CTL, 0, CTL_ZERO_BYTES, stream) != hipSuccess) { fprintf(stderr, "kernel_launch: hipMemsetAsync failed\n"); return; }
    Args a{};
    for (int i = 0; i < 20; ++i) a.in[i] = (const float*)d_in[i];
    a.out = (float*)d_out; a.ws = (unsigned char*)d_ws;
    for (int li = 0; li < N_LAUNCHES; ++li) {
        a.ph_lo = (N_LAUNCHES == 1) ? 0 : li; a.ph_hi = (N_LAUNCHES == 1) ? N_PHASES : li + 1; a.li = li; a.pad = 0;
        hipLaunchKernelGGL(mk_fwd, dim3(grid), dim3(NWAVES * 64), LDS_BYTES, stream, a);
        const hipError_t le = hipPeekAtLastError();
        if (le != hipSuccess) { fprintf(stderr, "kernel_launch: launch %d failed: %s\n", li, hipGetErrorName(le)); break; }
    }
}
```

```cpp
#include <hip/hip_runtime.h>
#include <cstdio>
#include <cstdint>
namespace pg8 {
#define PG8_LAS __attribute__((address_space(3)))
typedef unsigned short bf16_t;
typedef short bf16x8 __attribute__((ext_vector_type(8)));
typedef float f32x4 __attribute__((ext_vector_type(4)));
typedef unsigned u32x4 __attribute__((ext_vector_type(4)));
constexpr int BM = 256, BK = 64, HALF = 128, HTB = HALF * BK * 2  , STAGE_BYTES = 8 * HTB, NXCD = 8, WGM = 8;

__host__ __device__ __forceinline__ int lds_byte(int r, int c) { const int st = (r >> 4) * 2 + (c >> 5), rr = r & 15, cc = c & 31, ob = rr * 64 + cc * 2; return st * 1024 + (ob ^ (((ob >> 9) & 1) << 5)); }
__host__ __device__ __forceinline__ void stage_rc(int b, int& R, int& C) { const int st = b / 1024, sb = b % 1024, swz = sb ^ (((sb >> 9) & 1) << 5); R = (st >> 1) * 16 + swz / 64; C = (st & 1) * 32 + (swz % 64) / 2; }
__host__ __device__ __forceinline__ int perm32(int rho) { const int n = rho >> 4, i = rho & 15; return 8 * (i >> 2) + 4 * n + (i & 3); }

struct Unit { int pm, pn, kt0, knt, ks; };
struct Gemm { const bf16_t* A; const bf16_t* Bt; int M, N, K; size_t a_gbytes; int npg; };

struct StaticOrder {
    int nM, nN, nwg, G, c, wgm;
    __host__ __device__ void init(int M, int N, int G_, int c_, int wgm_ = WGM) { nM = M / BM; nN = N / BM; nwg = nM * nN; G = G_; c = c_; wgm = wgm_; }
    __host__ __device__ __forceinline__ bool next(int i, Unit& u) const {
        const long L = (long)i * G + c; if (L >= nwg) return false;
        int wgid = (int)L; { const int q = nwg / NXCD, r = nwg % NXCD, xcd = wgid % NXCD, off = wgid / NXCD; wgid = (xcd < r ? xcd * (q + 1) : r * (q + 1) + (xcd - r) * q) + off; }
        const int nig = wgm * nN, gid = wgid / nig, fm = gid * wgm, gsz = (nM - fm) < wgm ? (nM - fm) : wgm;
        u.pm = fm + ((wgid % nig) % gsz); u.pn = (wgid % nig) / gsz; u.kt0 = 0; u.knt = 0; u.ks = 0; return true;
    }
    __device__ __forceinline__ void a_ready(const Unit&) const {}
    __device__ __forceinline__ void done(const Unit&) const {}
};

struct AbsOrder {
    StaticOrder so; int c, nabs, R, rem;
    __host__ __device__ static int fit(int nwg, int G, int want) { const int R = nwg / G, rem = nwg % G; int n = want; if (n < 0) n = 0; while (n > 0 && !(rem <= G - n && G - n - rem >= n * R)) --n; return n; }
    __host__ __device__ void init(int M, int N, int G_, int c_, int nabs_, int wgm_ = WGM) { so.init(M, N, G_, 0, wgm_); c = c_; nabs = nabs_; R = so.nwg / G_; rem = so.nwg % G_; }
    __host__ __device__ __forceinline__ bool next(int i, Unit& u) const {
        if (c >= so.G - nabs) return false;
        StaticOrder t = so;
        if (i < R) { t.c = c; return t.next(i, u); }
        if (i > R) return false;
        if (c < rem) { t.c = c; return t.next(R, u); }
        const int o = c - rem; if (nabs == 0 || o >= nabs * R) return false;
        t.c = so.G - nabs + o % nabs; return t.next(o / nabs, u);
    }
    __device__ __forceinline__ void a_ready(const Unit&) const {}
    __device__ __forceinline__ void done(const Unit&) const {}
};

struct SplitOrder {
    StaticOrder so; int G, c, npn, nsplit, nt_full;
    __host__ __device__ void init(int Mp, int N, int K, int G_, int c_, int nsplit_, int wgm_ = WGM) { so.init(Mp, N, G_, c_, wgm_); G = G_; c = c_; npn = N / BM; nsplit = nsplit_; nt_full = K / BK; }
    __host__ __device__ __forceinline__ int kt_of(int s) const { const int pairs = nt_full / 2, q = pairs / nsplit, r = pairs % nsplit; return 2 * (s * q + (s < r ? s : r)); }
    __host__ __device__ __forceinline__ bool next(int i, Unit& u) const {
        if (so.next(i, u)) return true;
        const long L = (long)i * G + c - so.nwg; if (L < 0 || L >= (long)npn * nsplit) return false;
        const int s = (int)L / npn; u.pm = so.nM; u.pn = (int)L % npn; u.kt0 = kt_of(s); u.knt = kt_of(s + 1) - u.kt0; u.ks = s; return true;
    }
    __device__ __forceinline__ void a_ready(const Unit&) const {}
    __device__ __forceinline__ void done(const Unit&) const {}
};

struct QuadOrder {
    int nquad, G, c, nfull, nown, nleft4;
    __host__ __device__ void init(int M, int G_, int c_) { nquad = (M / BM) * 4; G = G_; c = c_; nown = nquad / G; nfull = nown * G; nleft4 = 4 * (nquad - nfull); }
    __host__ __device__ __forceinline__ bool has_left() const { return c < nleft4; }
    __host__ __device__ __forceinline__ int left_quad() const { return nfull + (c >> 2); }
    __host__ __device__ __forceinline__ bool next(int i, Unit& u) const {
        int quad, sub;
        if (i < 4 * nown) { quad = c + (i >> 2) * G; sub = i & 3; }
        else if (i == 4 * nown && has_left()) { quad = left_quad(); sub = c & 3; }
        else return false;
        u.pm = quad >> 2; u.pn = (quad & 3) * 4 + sub; u.kt0 = 0; u.knt = 0; u.ks = 0; return true;
    }
    __device__ __forceinline__ void a_ready(const Unit&) const {}
    __device__ __forceinline__ void done(const Unit&) const {}
};
typedef float f32x2 __attribute__((ext_vector_type(2)));
typedef __bf16 bf16x2_t __attribute__((ext_vector_type(2)));
__device__ __forceinline__ unsigned cvt_pk_bf16(float lo, float hi) { f32x2 v = {lo, hi}; bf16x2_t b = __builtin_convertvector(v, bf16x2_t); return __builtin_bit_cast(unsigned, b); }
__device__ __forceinline__ float bf_lo(unsigned w) { return __uint_as_float(w << 16); }
__device__ __forceinline__ float bf_hi(unsigned w) { return __uint_as_float(w & 0xffff0000u); }
__device__ __forceinline__ float fsigmoid(float x) { return __builtin_amdgcn_rcpf(1.0f + __builtin_amdgcn_exp2f(-1.4426950408889634f * x)); }
__device__ __forceinline__ u32x4 pack8(const f32x4 a, const f32x4 b) { u32x4 w; w.x = cvt_pk_bf16(a[0], a[1]); w.y = cvt_pk_bf16(a[2], a[3]); w.z = cvt_pk_bf16(b[0], b[1]); w.w = cvt_pk_bf16(b[2], b[3]); return w; }

struct EpiInProj {
    static constexpr bool PERM = true, AFTER_DRAIN = false;
    bf16_t *U, *Q, *K, *V, *GA, *GB, *SK, *SV; float *nv_p, *nv_s, *nk_p, *nk_s; const float *qg, *kg; PG8_LAS float* xs; float qscale;
    __device__ __forceinline__ void operator()(const f32x4 (&acc)[2][2][4][2], const Unit& u, int wr, int wc, int fr, int fq) const {
        asm volatile("" : "+v"(fr), "+v"(fq));
        const int pn = u.pn; bf16_t* base; int ldc = 4096, ct, type = 0;
        if (pn < 8) { base = U; ldc = 2048; ct = pn; }
        else if (pn < 24) { base = Q; ct = pn - 8; type = 3; }
        else if (pn < 40) { base = K; ct = pn - 24; type = 4; }
        else if (pn < 56) { base = V; ct = pn - 40; type = 1; }
        else if (pn < 72) { base = GA; ct = pn - 56; type = 2; }
        else { base = GB; ct = pn - 72; type = 2; }
        const bool samp = u.pm >= 64;
        const int rt0 = wr * 64 + fr, row0 = u.pm * BM + rt0, col0 = ct * BM + wc * 32 + 8 * fq;
        if (type >= 3) {
#pragma unroll
            for (int ai = 0; ai < 2; ++ai)
#pragma unroll
                for (int m = 0; m < 4; ++m) {
#pragma unroll
                    for (int bj = 0; bj < 2; ++bj) { const f32x4 a = acc[ai][bj][m][0], b = acc[ai][bj][m][1];
                        float s = (a[0] * a[0] + a[1] * a[1]) + (a[2] * a[2] + a[3] * a[3]) + (b[0] * b[0] + b[1] * b[1]) + (b[2] * b[2] + b[3] * b[3]);
                        s += __shfl_xor(s, 16); s += __shfl_xor(s, 32);
                        if (fq == 0) xs[((rt0 + ai * HALF + m * 16) * 2 + bj) * 4 + wc] = s; }
                    asm volatile("" ::: "memory"); }
            asm volatile("s_waitcnt lgkmcnt(0)\n\ts_barrier" ::: "memory");
            const float* gp = (type == 3 ? qg : kg) + wc * 32 + 8 * fq; const f32x4 g0 = *(const f32x4*)gp, g1 = *(const f32x4*)(gp + 4);
            const float sc = (type == 3) ? qscale : 1.0f;
            float* nk = samp ? nk_s + (size_t)(row0 - 16384) * 4096 : nk_p + (size_t)row0 * 4096;
#pragma unroll
            for (int ai = 0; ai < 2; ++ai)
#pragma unroll
                for (int m = 0; m < 4; ++m) { const int rt = rt0 + ai * HALF + m * 16; bf16_t* rowp = base + ((size_t)u.pm * BM + rt) * 4096 + col0;
                    bf16_t* skp = SK + ((size_t)(rt >> 5) * 1088 + 1024 + (rt & 31)) * 4096 + col0;
#pragma unroll
                    for (int bj = 0; bj < 2; ++bj) { const f32x4 t = *(const PG8_LAS f32x4*)(xs + (rt * 2 + bj) * 4);
                        const float rs = __builtin_amdgcn_rsqf(((t[0] + t[1]) + (t[2] + t[3])) * (1.0f / 128.0f) + 1e-6f) * sc;
                        const f32x4 v0 = acc[ai][bj][m][0] * rs * g0, v1 = acc[ai][bj][m][1] * rs * g1;
                        const u32x4 w = pack8(v0, v1);
                        *(u32x4*)(rowp + bj * HALF) = w;
                        if (type == 4) { float* kp = nk + (size_t)(ai * HALF + m * 16) * 4096 + col0 + bj * HALF; *(f32x4*)kp = v0; *(f32x4*)(kp + 4) = v1;
                            if (samp) *(u32x4*)(skp + bj * HALF) = w; } }
                    asm volatile("" ::: "memory"); }
            return;
        }
        float* vout = samp ? nv_s + (size_t)(row0 - 16384) * 4096 : nv_p + (size_t)row0 * 4096;
#pragma unroll
        for (int ai = 0; ai < 2; ++ai)
#pragma unroll
            for (int m = 0; m < 4; ++m) { const size_t roff = (size_t)(ai * HALF + m * 16); bf16_t* rowp = base + ((size_t)row0 + roff) * ldc + col0;
                const int rt = rt0 + ai * HALF + m * 16; bf16_t* svp = SV + ((size_t)(rt >> 5) * 1088 + 1024 + (rt & 31)) * 4096 + col0;
#pragma unroll
                for (int bj = 0; bj < 2; ++bj) { f32x4 v0 = acc[ai][bj][m][0], v1 = acc[ai][bj][m][1];
                    if (type == 1) { float* vp = vout + roff * 4096 + col0 + bj * HALF; *(f32x4*)vp = v0; *(f32x4*)(vp + 4) = v1; }
                    if (type == 2) {
#pragma unroll
                        for (int e = 0; e < 4; ++e) { v0[e] = fsigmoid(v0[e]); v1[e] = fsigmoid(v1[e]); } }
                    const u32x4 w = pack8(v0, v1);
                    *(u32x4*)(rowp + bj * HALF) = w;
                    if (type == 1 && samp) *(u32x4*)(svp + bj * HALF) = w; } }
    }
};

struct EpiPool {
    static constexpr bool PERM = true, AFTER_DRAIN = false;
    bf16_t* GA; const float* pscale;
    __device__ __forceinline__ void operator()(const f32x4 (&acc)[2][2][4][2], const Unit& u, int wr, int wc, int fr, int fq) const {
        asm volatile("" : "+v"(fr), "+v"(fq));
        const int row0 = u.pm * BM + wr * 64 + fr, col0 = u.pn * BM + wc * 32 + 8 * fq;
        f32x4 ps[2][2];
#pragma unroll
        for (int bj = 0; bj < 2; ++bj)
#pragma unroll
            for (int n = 0; n < 2; ++n) ps[bj][n] = *(const f32x4*)(pscale + col0 + bj * HALF + 4 * n);
        u32x4 gwv[2][4][2];
#pragma unroll
        for (int ai = 0; ai < 2; ++ai)
#pragma unroll
            for (int m = 0; m < 4; ++m)
#pragma unroll
                for (int bj = 0; bj < 2; ++bj) gwv[ai][m][bj] = *(const u32x4*)(GA + (size_t)(row0 + ai * HALF + m * 16) * 4096 + col0 + bj * HALF);
#pragma unroll
        for (int ai = 0; ai < 2; ++ai)
#pragma unroll
            for (int m = 0; m < 4; ++m) { bf16_t* rowp = GA + (size_t)(row0 + ai * HALF + m * 16) * 4096 + col0;
#pragma unroll
                for (int bj = 0; bj < 2; ++bj) { const u32x4 gw = gwv[ai][m][bj];
                    f32x4 v0 = acc[ai][bj][m][0] * ps[bj][0], v1 = acc[ai][bj][m][1] * ps[bj][1];
                    v0[0] *= bf_lo(gw.x); v0[1] *= bf_hi(gw.x); v0[2] *= bf_lo(gw.y); v0[3] *= bf_hi(gw.y);
                    v1[0] *= bf_lo(gw.z); v1[1] *= bf_hi(gw.z); v1[2] *= bf_lo(gw.w); v1[3] *= bf_hi(gw.w);
                    *(u32x4*)(rowp + bj * HALF) = pack8(v0, v1); } }
    }
};

struct EpiWout {
    static constexpr bool PERM = true, AFTER_DRAIN = false;
    const float *xp, *xs; float* y; bf16_t* X1n; const float* gffn; float* rowss;
    __device__ __forceinline__ void operator()(const f32x4 (&acc)[2][2][4][2], const Unit& u, int wr, int wc, int fr, int fq) const {
        asm volatile("" : "+v"(fr), "+v"(fq));
        const int row0 = u.pm * BM + wr * 64 + fr, col0 = u.pn * BM + wc * 32 + 8 * fq;
        const float* xb = (u.pm < 64) ? xp + (size_t)row0 * 4096 : xs + (size_t)(row0 - 16384) * 4096;
        f32x4 gf[2][2];
#pragma unroll
        for (int bj = 0; bj < 2; ++bj)
#pragma unroll
            for (int n = 0; n < 2; ++n) gf[bj][n] = *(const f32x4*)(gffn + col0 + bj * HALF + 4 * n);
#pragma unroll
        for (int ai = 0; ai < 2; ++ai) {
            f32x4 xv[4][2][2];
#pragma unroll
            for (int m = 0; m < 4; ++m)
#pragma unroll
                for (int bj = 0; bj < 2; ++bj) { const float* p = xb + (size_t)(ai * HALF + m * 16) * 4096 + col0 + bj * HALF; xv[m][bj][0] = *(const f32x4*)p; xv[m][bj][1] = *(const f32x4*)(p + 4); }
#pragma unroll
            for (int m = 0; m < 4; ++m) { const size_t roff = (size_t)(ai * HALF + m * 16); float ss = 0.f;
#pragma unroll
                for (int bj = 0; bj < 2; ++bj) { const int c = col0 + bj * HALF;
                    const f32x4 a = xv[m][bj][0] + acc[ai][bj][m][0], b = xv[m][bj][1] + acc[ai][bj][m][1];
                    float* yp = y + ((size_t)row0 + roff) * 4096 + c; *(f32x4*)yp = a; *(f32x4*)(yp + 4) = b;
                    ss += (a[0] * a[0] + a[1] * a[1]) + (a[2] * a[2] + a[3] * a[3]) + (b[0] * b[0] + b[1] * b[1]) + (b[2] * b[2] + b[3] * b[3]);
                    *(u32x4*)(X1n + ((size_t)row0 + roff) * 4096 + c) = pack8(a * gf[bj][0], b * gf[bj][1]); }
                ss += __shfl_xor(ss, 16); ss += __shfl_xor(ss, 32);
                if (fq == 0) (void)__hip_atomic_fetch_add(rowss + row0 + (int)roff, ss, __ATOMIC_RELAXED, __HIP_MEMORY_SCOPE_AGENT); }
            asm volatile("" ::: "memory"); }
    }
};

struct EpiSwiGLU {
    static constexpr bool PERM = true, AFTER_DRAIN = false;
    bf16_t* Hff; const float* rowss;
    __device__ __forceinline__ void operator()(const f32x4 (&acc)[2][2][4][2], const Unit& u, int wr, int wc, int fr, int fq) const {
        asm volatile("" : "+v"(fr), "+v"(fq));
        const int row0 = u.pm * BM + wr * 64 + fr, col0 = u.pn * HALF + wc * 32 + 8 * fq;
        float ssq[2][4];
#pragma unroll
        for (int ai = 0; ai < 2; ++ai)
#pragma unroll
            for (int m = 0; m < 4; ++m) ssq[ai][m] = __hip_atomic_load(rowss + row0 + ai * HALF + m * 16, __ATOMIC_RELAXED, __HIP_MEMORY_SCOPE_AGENT);
#pragma unroll
        for (int ai = 0; ai < 2; ++ai)
#pragma unroll
            for (int m = 0; m < 4; ++m) { const int r = row0 + ai * HALF + m * 16;
                const float rs = __builtin_amdgcn_rsqf(ssq[ai][m] * (1.0f / 4096.0f) + 1e-6f);
                f32x4 g0 = acc[ai][0][m][0] * rs, g1 = acc[ai][0][m][1] * rs, u0 = acc[ai][1][m][0] * rs, u1 = acc[ai][1][m][1] * rs;
#pragma unroll
                for (int e = 0; e < 4; ++e) { g0[e] = g0[e] * fsigmoid(g0[e]) * u0[e]; g1[e] = g1[e] * fsigmoid(g1[e]) * u1[e]; }
                *(u32x4*)(Hff + (size_t)r * 11008 + col0) = pack8(g0, g1); }
    }
};

struct EpiFfnOut {
    static constexpr bool PERM = true, AFTER_DRAIN = false;
    float* y; float* part;
    __device__ __forceinline__ void operator()(const f32x4 (&acc)[2][2][4][2], const Unit& u, int wr, int wc, int fr, int fq) const {
        asm volatile("" : "+v"(fr), "+v"(fq));
        const int rt0 = wr * 64 + fr, col0 = u.pn * BM + wc * 32 + 8 * fq;
        if (u.knt == 0) {
#pragma unroll
            for (int ai = 0; ai < 2; ++ai) {
                f32x4 yv[4][2][2];
#pragma unroll
                for (int m = 0; m < 4; ++m)
#pragma unroll
                    for (int bj = 0; bj < 2; ++bj) { const float* rp = y + (size_t)(u.pm * BM + rt0 + ai * HALF + m * 16) * 4096 + col0 + bj * HALF; yv[m][bj][0] = *(const f32x4*)rp; yv[m][bj][1] = *(const f32x4*)(rp + 4); }
#pragma unroll
                for (int m = 0; m < 4; ++m)
#pragma unroll
                    for (int bj = 0; bj < 2; ++bj) { float* rp = y + (size_t)(u.pm * BM + rt0 + ai * HALF + m * 16) * 4096 + col0 + bj * HALF;
                        *(f32x4*)rp = yv[m][bj][0] + acc[ai][bj][m][0]; *(f32x4*)(rp + 4) = yv[m][bj][1] + acc[ai][bj][m][1]; }
                asm volatile("" ::: "memory"); }
        } else {
#pragma unroll
            for (int ai = 0; ai < 2; ++ai)
#pragma unroll
                for (int m = 0; m < 4; ++m) { float* rp = part + ((size_t)u.ks * BM + rt0 + ai * HALF + m * 16) * 4096 + col0;
#pragma unroll
                    for (int bj = 0; bj < 2; ++bj) { *(f32x4*)(rp + bj * HALF) = acc[ai][bj][m][0]; *(f32x4*)(rp + bj * HALF + 4) = acc[ai][bj][m][1]; } }
        }
    }
};

template <class Epi, class Sched, bool ALIGN_EPI = false, bool SP2 = false>
__device__ __forceinline__ void gemm_phase(PG8_LAS unsigned char* lds, const Gemm g, const Sched& S, const Epi& E) {
    const int tid = threadIdx.x, wid = __builtin_amdgcn_readfirstlane(tid >> 6), lane = tid & 63, wr = wid >> 2, wc = wid & 3, fr = lane & 15, fq = lane >> 4;
    const int K = g.K, nt_full = K / BK;
    unsigned voffA[2], voffB[2];
#pragma unroll
    for (int i = 0; i < 2; ++i) { int R, C; stage_rc(tid * 16 + i * 8192, R, C); const int Rb = Epi::PERM ? ((R & ~31) + perm32(R & 31)) : R;
        voffA[i] = (unsigned)(R * K + C) * 2u; voffB[i] = (unsigned)(Rb * K + C) * 2u; }
    const size_t kstep = (size_t)(BK * 2);
    const size_t hstep = (size_t)HALF * K * 2;
    const size_t tstep = 2 * hstep;
    const unsigned ldsw = (unsigned)wid * 1024u;
    const int aoff = lds_byte(wr * 64 + fr, fq * 8), boff = lds_byte(wc * 32 + fr, fq * 8);
#define PG8_SA(b, h) (((b) * 2 + (h)) * HTB)
#define PG8_SB(b, h) ((4 + (b) * 2 + (h)) * HTB)
#define PG8_STAGE(bufoff, gbase, voff) do { _Pragma("unroll") for (int _i = 0; _i < 2; ++_i) \
        __builtin_amdgcn_global_load_lds((const unsigned*)((const char*)(gbase) + (voff)[_i]), (PG8_LAS unsigned*)(lds + (bufoff) + ldsw + _i * 8192), 16, 0, 0); } while (0)
#define PG8_LDA(dst, b, h) do { _Pragma("unroll") for (int m = 0; m < 4; ++m) _Pragma("unroll") for (int k = 0; k < 2; ++k) dst[m][k] = *(const PG8_LAS bf16x8*)(lds + PG8_SA(b, h) + aoff + m * 2048 + k * 1024); } while (0)
#define PG8_LDB(dst, b, h) do { _Pragma("unroll") for (int n = 0; n < 2; ++n) _Pragma("unroll") for (int k = 0; k < 2; ++k) dst[n][k] = *(const PG8_LAS bf16x8*)(lds + PG8_SB(b, h) + boff + n * 2048 + k * 1024); } while (0)
#define PG8_MMA(ai, bj, At, Bt) do { __builtin_amdgcn_s_setprio(1); _Pragma("unroll") for (int m = 0; m < 4; ++m) _Pragma("unroll") for (int n = 0; n < 2; ++n) _Pragma("unroll") for (int k = 0; k < 2; ++k) \
        acc[ai][bj][m][n] = __builtin_amdgcn_mfma_f32_16x16x32_bf16(Bt[n][k], At[m][k], acc[ai][bj][m][n], 0, 0, 0); __builtin_amdgcn_s_setprio(0); } while (0)
#define PG8_WAIT_V(n) asm volatile("s_waitcnt vmcnt(" #n ")" ::: "memory")
#define PG8_WAIT_L(n) asm volatile("s_waitcnt lgkmcnt(" #n ")" ::: "memory")
#define PG8_BAR __builtin_amdgcn_s_barrier()
#define PG8_SCHED __builtin_amdgcn_sched_barrier(0)
    Unit cur = {0, 0, 0, 0, 0}, nxt = {0, 0, 0, 0, 0}; int ui = 0;
    if (!S.next(0, cur)) return;
    f32x4 acc[2][2][4][2];
#pragma unroll
    for (int a = 0; a < 2; ++a)
#pragma unroll
        for (int b = 0; b < 2; ++b)
#pragma unroll
            for (int m = 0; m < 4; ++m)
#pragma unroll
                for (int n = 0; n < 2; ++n) acc[a][b][m][n] = (f32x4){0.f, 0.f, 0.f, 0.f};
    bf16x8 At[4][2], B0[2][2], B1[2][2];
    const char* cA = (const char*)g.A + (size_t)cur.pm * tstep + (g.npg ? (size_t)(cur.pn / g.npg) * g.a_gbytes : (size_t)0) + (size_t)cur.kt0 * kstep; const char* cB = (const char*)g.Bt + (size_t)cur.pn * tstep + (size_t)cur.kt0 * kstep;
    S.a_ready(cur);
    if constexpr (SP2) {
        PG8_STAGE(PG8_SB(0, 0), cB, voffB); PG8_STAGE(PG8_SB(0, 1), cB + hstep, voffB); PG8_STAGE(PG8_SA(0, 0), cA, voffA); PG8_STAGE(PG8_SA(0, 1), cA + hstep, voffA);
        if (wr == 1) PG8_BAR;
        PG8_WAIT_V(2); PG8_BAR;
        PG8_STAGE(PG8_SB(1, 0), cB + kstep, voffB); PG8_STAGE(PG8_SA(1, 0), cA + kstep, voffA); PG8_STAGE(PG8_SB(1, 1), cB + hstep + kstep, voffB);
        PG8_WAIT_V(6); PG8_BAR;
    } else {
        PG8_STAGE(PG8_SB(0, 0), cB, voffB); PG8_STAGE(PG8_SA(0, 0), cA, voffA); PG8_STAGE(PG8_SB(0, 1), cB + hstep, voffB); PG8_STAGE(PG8_SA(0, 1), cA + hstep, voffA);
        if (wr == 1) PG8_BAR;
        PG8_WAIT_V(4); PG8_BAR;
        PG8_STAGE(PG8_SB(1, 0), cB + kstep, voffB); PG8_STAGE(PG8_SA(1, 0), cA + kstep, voffA); PG8_STAGE(PG8_SB(1, 1), cB + hstep + kstep, voffB);
        PG8_WAIT_V(6); PG8_BAR;
    }
    for (;;) {
        const bool has_next = S.next(ui + 1, nxt);
        const char* nA = has_next ? (const char*)g.A + (size_t)nxt.pm * tstep + (g.npg ? (size_t)(nxt.pn / g.npg) * g.a_gbytes : (size_t)0) + (size_t)nxt.kt0 * kstep : cA; const char* nB = has_next ? (const char*)g.Bt + (size_t)nxt.pn * tstep + (size_t)nxt.kt0 * kstep : cB;
        const int nt = cur.knt ? cur.knt : nt_full;
        for (int t = 0; t < nt; t += 2) {
            const bool last = (t == nt - 2);
            const char* a1 = cA + (size_t)(t + 1) * kstep;
            const char* a2 = last ? nA : cA + (size_t)(t + 2) * kstep; const char* b2 = last ? nB : cB + (size_t)(t + 2) * kstep;
            const char* a3 = a2 + kstep; const char* b3 = b2 + kstep;
            if (last && has_next) S.a_ready(nxt);
            if constexpr (SP2) {
            PG8_LDB(B0, 0, 0); PG8_LDB(B1, 0, 1); PG8_SCHED; PG8_LDA(At, 0, 0); PG8_STAGE(PG8_SA(1, 1), a1 + hstep, voffA);
            PG8_WAIT_V(8); PG8_WAIT_L(0); PG8_BAR; PG8_MMA(0, 0, At, B0); PG8_MMA(0, 1, At, B1); PG8_BAR; PG8_SCHED;
            PG8_LDA(At, 0, 1); PG8_STAGE(PG8_SB(0, 0), b2, voffB); PG8_STAGE(PG8_SB(0, 1), b2 + hstep, voffB); PG8_STAGE(PG8_SA(0, 0), a2, voffA);
            PG8_WAIT_V(8); PG8_WAIT_L(0); PG8_BAR; PG8_MMA(1, 0, At, B0); PG8_MMA(1, 1, At, B1); PG8_BAR; PG8_SCHED;
            PG8_LDB(B0, 1, 0); PG8_LDB(B1, 1, 1); PG8_SCHED; PG8_LDA(At, 1, 0); PG8_STAGE(PG8_SA(0, 1), a2 + hstep, voffA);
            PG8_WAIT_V(8); PG8_WAIT_L(0); PG8_BAR; PG8_MMA(0, 0, At, B0); PG8_MMA(0, 1, At, B1); PG8_BAR; PG8_SCHED;
            PG8_LDA(At, 1, 1); PG8_STAGE(PG8_SB(1, 0), b3, voffB); PG8_STAGE(PG8_SB(1, 1), b3 + hstep, voffB); PG8_STAGE(PG8_SA(1, 0), a3, voffA);
            PG8_WAIT_V(8); PG8_WAIT_L(0); PG8_BAR; PG8_MMA(1, 0, At, B0); PG8_MMA(1, 1, At, B1); PG8_BAR; PG8_SCHED;
            } else {
            PG8_LDB(B0, 0, 0); PG8_SCHED; PG8_LDA(At, 0, 0); PG8_STAGE(PG8_SA(1, 1), a1 + hstep, voffA);
            PG8_WAIT_L(8); PG8_BAR; PG8_WAIT_L(0); PG8_MMA(0, 0, At, B0); PG8_BAR; PG8_SCHED;
            PG8_LDB(B1, 0, 1); PG8_STAGE(PG8_SB(0, 0), b2, voffB);
            PG8_BAR; PG8_WAIT_L(0); PG8_MMA(0, 1, At, B1); PG8_BAR;
            PG8_LDA(At, 0, 1); PG8_STAGE(PG8_SA(0, 0), a2, voffA);
            PG8_BAR; PG8_WAIT_L(0); PG8_MMA(1, 0, At, B0); PG8_BAR; PG8_SCHED;
            PG8_STAGE(PG8_SB(0, 1), b2 + hstep, voffB);
            PG8_WAIT_V(6); PG8_BAR; PG8_MMA(1, 1, At, B1); PG8_BAR;
            PG8_LDB(B0, 1, 0); PG8_SCHED; PG8_LDA(At, 1, 0); PG8_STAGE(PG8_SA(0, 1), a2 + hstep, voffA);
            PG8_WAIT_L(8); PG8_BAR; PG8_WAIT_L(0); PG8_MMA(0, 0, At, B0); PG8_BAR; PG8_SCHED;
            PG8_LDB(B1, 1, 1); PG8_STAGE(PG8_SB(1, 0), b3, voffB);
            PG8_BAR; PG8_WAIT_L(0); PG8_MMA(0, 1, At, B1); PG8_BAR;
            PG8_LDA(At, 1, 1); PG8_STAGE(PG8_SA(1, 0), a3, voffA);
            PG8_BAR; PG8_WAIT_L(0); PG8_MMA(1, 0, At, B0); PG8_BAR; PG8_SCHED;
            PG8_STAGE(PG8_SB(1, 1), b3 + hstep, voffB);
            PG8_WAIT_V(6); PG8_BAR; PG8_MMA(1, 1, At, B1); PG8_BAR;
            }
        }
        if constexpr (ALIGN_EPI) { if (wr == 0) PG8_BAR; }
        if constexpr (!Epi::AFTER_DRAIN) { E(acc, cur, wr, wc, fr, fq); S.done(cur); }
        if (!has_next) break;
#pragma unroll
        for (int a = 0; a < 2; ++a)
#pragma unroll
            for (int b = 0; b < 2; ++b)
#pragma unroll
                for (int m = 0; m < 4; ++m)
#pragma unroll
                    for (int n = 0; n < 2; ++n) acc[a][b][m][n] = (f32x4){0.f, 0.f, 0.f, 0.f};
        cur = nxt; cA = nA; cB = nB; ++ui;
        if constexpr (ALIGN_EPI) { if (wr == 1) PG8_BAR; }
    }
    PG8_WAIT_V(0);
    if constexpr (!ALIGN_EPI) { if (wr == 0) PG8_BAR; }
    PG8_BAR;
    if constexpr (Epi::AFTER_DRAIN) { E.fused(acc, cur, wr, wc, fr, fq, lds, wid, lane); S.done(cur); }
#undef PG8_SA
#undef PG8_SB
#undef PG8_STAGE
#undef PG8_LDA
#undef PG8_LDB
#undef PG8_MMA
#undef PG8_WAIT_V
#undef PG8_WAIT_L
#undef PG8_BAR
#undef PG8_SCHED
}
}
namespace da {
using pg8::bf16_t;
typedef short bf16x8 __attribute__((ext_vector_type(8)));
typedef short s16x4 __attribute__((ext_vector_type(4)));
typedef float f32x4 __attribute__((ext_vector_type(4)));
typedef unsigned u32x4 __attribute__((ext_vector_type(4)));
#define DA_LAS __attribute__((address_space(3)))
#define DA_SBAR() __builtin_amdgcn_sched_barrier(0)
constexpr int PITCH = 4096;
constexpr int ST_BYTES = 32768;
constexpr int OFF_V = 65536;
constexpr int LDS_SCR = 131072;
constexpr int LDS_NEED = LDS_SCR + 8 * 256;

__device__ __forceinline__ void glds16(const void* gsrc, unsigned lds_dst) { unsigned keep;
    asm volatile("s_mov_b32 %0, m0\n\ts_mov_b32 m0, %2\n\ts_nop 0\n\tglobal_load_lds_dwordx4 %1, off\n\ts_mov_b32 m0, %0" : "=&s"(keep) : "v"(gsrc), "s"(lds_dst) : "memory"); }
template <int OFF> __device__ __forceinline__ s16x4 tr_read(int vb) { s16x4 r; asm volatile("ds_read_b64_tr_b16 %0, %1 offset:%2" : "=&v"(r) : "v"(vb), "i"(OFF) : "memory"); return r; }
template <int OFF> __device__ __forceinline__ bf16x8 k_read(int ad) { bf16x8 r; asm volatile("ds_read_b128 %0, %1 offset:%2" : "=&v"(r) : "v"(ad), "i"(OFF) : "memory"); return r; }

struct Unit {
    const bf16_t* Q; bf16_t* O;
    const bf16_t* K; const bf16_t* V;
    bf16_t* GA; const bf16_t* GB;
    int nt, nt_lo, nt_hi;
    int sample;
};

__device__ __forceinline__ void attn_unit(const Unit& u, DA_LAS unsigned char* lds, float lam, float Mshift, const float* subln) {
    const int tid = threadIdx.x, lane = tid & 63, c16 = lane & 15, g4 = lane >> 4; const int wid = __builtin_amdgcn_readfirstlane(tid >> 6);
    const int g = wid & 3, mp = wid >> 2;
    int my_nt = (g < 2) ? u.nt_lo : u.nt_hi; if (u.sample && g != 0) my_nt = 0;
    const unsigned lds0 = (unsigned)(size_t)lds;
    const bf16_t* src = (wid < 4) ? u.K : u.V;
#define DA_LOFF(p) ((wid < 4) ? (unsigned)((lane_ >> 4) * PITCH + (((lane_ & 15) ^ ((4 * (p) + (lane_ >> 4)) & 15)) * 8)) \
                              : (unsigned)((lane_ >> 5) * PITCH + (((lane_ & 31) ^ (4 * (p) + 2 * (lane_ >> 5))) * 8)))
#define DA_UOFF(i) ((wid < 4) ? (unsigned)((4 * ((wid * 8 + (i)) & 15)) * PITCH + (wid >> 1) * 128) : (unsigned)((16 * (wid - 4) + 2 * (i)) * PITCH))
#define DA_DMA(t, stg) do { int lane_ = lane; asm volatile("" : "+v"(lane_)); const bf16_t* sp_ = src + (size_t)(t) * 64 * PITCH; const unsigned ld_ = lds0 + (unsigned)(stg) * ST_BYTES + (wid < 4 ? (unsigned)wid * 8192u : (unsigned)(OFF_V + (wid - 4) * 8192)); \
        _Pragma("unroll") for (int i_ = 0; i_ < 8; ++i_) glds16(sp_ + (size_t)__builtin_amdgcn_readfirstlane(DA_UOFF(i_)) + DA_LOFF(i_ & 3), (unsigned)__builtin_amdgcn_readfirstlane(ld_ + i_ * 1024)); } while (0)
    DA_DMA(0, 0);
    bf16x8 qr[2][4];
    { const bf16_t* Qw = u.Q + (size_t)((my_nt > 0 ? g * 32 : 0) + c16) * PITCH + mp * 128 + g4 * 8;
#pragma unroll
      for (int qb = 0; qb < 2; ++qb)
#pragma unroll
        for (int ds = 0; ds < 4; ++ds) qr[qb][ds] = *(const bf16x8*)(Qw + (size_t)qb * 16 * PITCH + ds * 32); }
    asm volatile("" : "+v"(qr[0][0]), "+v"(qr[0][1]), "+v"(qr[0][2]), "+v"(qr[0][3]), "+v"(qr[1][0]), "+v"(qr[1][1]), "+v"(qr[1][2]), "+v"(qr[1][3]));
    f32x4 o[2][16];
#pragma unroll
    for (int qb = 0; qb < 2; ++qb)
#pragma unroll
        for (int cb = 0; cb < 16; ++cb) o[qb][cb] = (f32x4){0.f, 0.f, 0.f, 0.f};
    float lq0 = 0.f, lq1 = 0.f;
    const int klane = c16 * 256, vs2 = 4 * (g4 & 1) + (c16 >> 2);
    const int vlane = (4 * g4 + (c16 >> 2)) * 512 + ((c16 >> 1) & 1) * 16 + (c16 & 1) * 8;
    f32x4 negM = (f32x4){-Mshift, -Mshift, -Mshift, -Mshift}; asm volatile("" : "+v"(negM));
    bf16x8 pa[2][2];
#pragma unroll
    for (int s = 0; s < 2; ++s)
#pragma unroll
        for (int qb = 0; qb < 2; ++qb) pa[s][qb] = bf16x8{};
#define DA_W(n) do { asm volatile("s_waitcnt lgkmcnt(" #n ")" ::: "memory"); DA_SBAR(); } while (0)
#define DA_MF(a, b, c) __builtin_amdgcn_mfma_f32_16x16x32_bf16(a, b, c, 0, 0, 0)
#define DA_KRD4(KB, S) do { S##0 = k_read<(KB) * 4096>(kad0); S##1 = k_read<(KB) * 4096>(kad1); S##2 = k_read<(KB) * 4096>(kad2); S##3 = k_read<(KB) * 4096>(kad3); } while (0)
#define DA_QK8(KB, S, FIRST) do { \
        sT[KB][0] = DA_MF(S##0, qr[0][0], sT[KB][0]); sT[KB][1] = DA_MF(S##0, qr[1][0], sT[KB][1]); sT[KB][0] = DA_MF(S##1, qr[0][1], sT[KB][0]); sT[KB][1] = DA_MF(S##1, qr[1][1], sT[KB][1]); \
        sT[KB][0] = DA_MF(S##2, qr[0][2], sT[KB][0]); sT[KB][1] = DA_MF(S##2, qr[1][2], sT[KB][1]); sT[KB][0] = DA_MF(S##3, qr[0][3], sT[KB][0]); sT[KB][1] = DA_MF(S##3, qr[1][3], sT[KB][1]); } while (0)
#define DA_QKP(t) do { \
        const int kb_ = (int)lds0 + ((t) & 1) * 32768 + mp * 16384 + klane; \
        int kad0 = kb_ + (((0 + g4) ^ c16) << 4), kad1 = kb_ + (((4 + g4) ^ c16) << 4), kad2 = kb_ + (((8 + g4) ^ c16) << 4), kad3 = kb_ + (((12 + g4) ^ c16) << 4); \
        asm volatile("" : "+v"(kad0), "+v"(kad1), "+v"(kad2), "+v"(kad3)); \
        bf16x8 ka0, ka1, ka2, ka3, kc0, kc1, kc2, kc3; f32x4 sT[4][2]; \
        _Pragma("unroll") for (int kb = 0; kb < 4; ++kb) { sT[kb][0] = negM; sT[kb][1] = negM; } \
        DA_SBAR(); __builtin_amdgcn_s_setprio(3); DA_KRD4(0, ka); DA_KRD4(1, kc); \
        DA_W(4); DA_QK8(0, ka, true); DA_SBAR(); DA_KRD4(2, ka); \
        DA_W(4); DA_QK8(1, kc, true); DA_SBAR(); DA_KRD4(3, kc); \
        DA_W(4); DA_QK8(2, ka, true); DA_SBAR(); \
        DA_W(0); DA_QK8(3, kc, true); __builtin_amdgcn_s_setprio(0); DA_SBAR(); \
        _Pragma("unroll") for (int kb = 0; kb < 4; ++kb) _Pragma("unroll") for (int qb = 0; qb < 2; ++qb) _Pragma("unroll") for (int r = 0; r < 4; ++r) sT[kb][qb][r] = __builtin_amdgcn_exp2f(sT[kb][qb][r]); \
        if (u.sample && (t) == u.nt - 1) { _Pragma("unroll") for (int kb = 2; kb < 4; ++kb) _Pragma("unroll") for (int qb = 0; qb < 2; ++qb) sT[kb][qb] = (f32x4){0.f, 0.f, 0.f, 0.f}; } \
        _Pragma("unroll") for (int kb = 0; kb < 4; ++kb) { lq0 += (sT[kb][0][0] + sT[kb][0][1]) + (sT[kb][0][2] + sT[kb][0][3]); lq1 += (sT[kb][1][0] + sT[kb][1][1]) + (sT[kb][1][2] + sT[kb][1][3]); } \
        _Pragma("unroll") for (int s = 0; s < 2; ++s) _Pragma("unroll") for (int qb = 0; qb < 2; ++qb) { u32x4 w; \
            w.x = pg8::cvt_pk_bf16(sT[2 * s][qb][0], sT[2 * s][qb][1]); w.y = pg8::cvt_pk_bf16(sT[2 * s][qb][2], sT[2 * s][qb][3]); \
            w.z = pg8::cvt_pk_bf16(sT[2 * s + 1][qb][0], sT[2 * s + 1][qb][1]); w.w = pg8::cvt_pk_bf16(sT[2 * s + 1][qb][2], sT[2 * s + 1][qb][3]); pa[s][qb] = __builtin_bit_cast(bf16x8, w); } } while (0)
#define DA_VRD(CB, S) do { const int a0_ = vad + (((((CB) & 7) ^ vs2)) << 5), a1_ = vad + ((((((CB) + 1) & 7) ^ vs2)) << 5); \
        S##l0 = tr_read<((CB) >> 3) * 256>(a0_); S##h0 = tr_read<((CB) >> 3) * 256 + 8192>(a0_); S##l1 = tr_read<((CB) >> 3) * 256 + 16384>(a0_); S##h1 = tr_read<((CB) >> 3) * 256 + 24576>(a0_); \
        S##l2 = tr_read<((CB) >> 3) * 256>(a1_); S##h2 = tr_read<((CB) >> 3) * 256 + 8192>(a1_); S##l3 = tr_read<((CB) >> 3) * 256 + 16384>(a1_); S##h3 = tr_read<((CB) >> 3) * 256 + 24576>(a1_); } while (0)
#define DA_VPK(L, H) (bf16x8){L[0], L[1], L[2], L[3], H[0], H[1], H[2], H[3]}
#define DA_VMM(CB, S) do { \
        o[0][CB] = DA_MF(pa[0][0], DA_VPK(S##l0, S##h0), o[0][CB]); o[1][CB] = DA_MF(pa[0][1], DA_VPK(S##l0, S##h0), o[1][CB]); \
        o[0][(CB) + 1] = DA_MF(pa[0][0], DA_VPK(S##l2, S##h2), o[0][(CB) + 1]); o[1][(CB) + 1] = DA_MF(pa[0][1], DA_VPK(S##l2, S##h2), o[1][(CB) + 1]); \
        o[0][CB] = DA_MF(pa[1][0], DA_VPK(S##l1, S##h1), o[0][CB]); o[1][CB] = DA_MF(pa[1][1], DA_VPK(S##l1, S##h1), o[1][CB]); \
        o[0][(CB) + 1] = DA_MF(pa[1][0], DA_VPK(S##l3, S##h3), o[0][(CB) + 1]); o[1][(CB) + 1] = DA_MF(pa[1][1], DA_VPK(S##l3, S##h3), o[1][(CB) + 1]); } while (0)
#define DA_PV(tv) do { int vad = (int)lds0 + OFF_V + ((tv) & 1) * 32768 + vlane; asm volatile("" : "+v"(vad)); \
        s16x4 Al0, Ah0, Al1, Ah1, Al2, Ah2, Al3, Ah3, Bl0, Bh0, Bl1, Bh1, Bl2, Bh2, Bl3, Bh3; \
        DA_SBAR(); DA_VRD(0, A); DA_VRD(2, B); DA_W(8); DA_VMM(0, A); DA_SBAR(); \
        DA_VRD(4, A); DA_W(8); DA_VMM(2, B); DA_SBAR(); \
        DA_VRD(6, B); DA_W(8); DA_VMM(4, A); DA_SBAR(); \
        DA_VRD(8, A); DA_W(8); DA_VMM(6, B); DA_SBAR(); \
        DA_VRD(10, B); DA_W(8); DA_VMM(8, A); DA_SBAR(); \
        DA_VRD(12, A); DA_W(8); DA_VMM(10, B); DA_SBAR(); \
        DA_VRD(14, B); DA_W(8); DA_VMM(12, A); DA_SBAR(); \
        DA_W(0); DA_VMM(14, B); DA_SBAR(); } while (0)
#define DA_BAR_V() asm volatile("s_waitcnt vmcnt(0) lgkmcnt(0)\n\ts_barrier" ::: "memory")
#define DA_BAR_L() asm volatile("s_waitcnt lgkmcnt(0)\n\ts_barrier" ::: "memory")
    if (mp == 1) DA_BAR_L();
    for (int t = 0; t < my_nt; ++t) {
        DA_BAR_V();
        if (t + 1 < u.nt) DA_DMA(t + 1, (t + 1) & 1);
        DA_QKP(t);
        DA_BAR_L();
        DA_PV(t);
    }
    for (int t = my_nt; t < u.nt; ++t) {
        DA_BAR_V();
        if (t + 1 < u.nt) DA_DMA(t + 1, (t + 1) & 1);
        DA_BAR_L();
    }
    if (mp == 0) DA_BAR_L();
#undef DA_BAR_V
#undef DA_BAR_L
#undef DA_QKP
#undef DA_QK8
#undef DA_KRD4
#undef DA_PV
#undef DA_VRD
#undef DA_VPK
#undef DA_VMM
#undef DA_DMA
#undef DA_UOFF
#undef DA_LOFF
    lq0 += __shfl_xor(lq0, 16); lq0 += __shfl_xor(lq0, 32); lq1 += __shfl_xor(lq1, 16); lq1 += __shfl_xor(lq1, 32);
    DA_LAS float* wsf = (DA_LAS float*)(lds + LDS_SCR + wid * 256);
    if (g4 == 0) { wsf[c16] = lq0; wsf[16 + c16] = lq1; }
    asm volatile("s_waitcnt lgkmcnt(0)" ::: "memory");
    float rli[2][4];
    const float sc = (mp == 1) ? lam : 1.0f;
#pragma unroll
    for (int qb = 0; qb < 2; ++qb)
#pragma unroll
        for (int r = 0; r < 4; ++r) rli[qb][r] = sc * __builtin_amdgcn_rcpf(wsf[16 * qb + 4 * g4 + r]);
    const size_t goff = (size_t)(g * 32 + 16 * mp + (lane >> 5)) * PITCH + (lane & 31) * 8;
    bf16_t* Ga = u.GA + goff; const bf16_t* Gb = u.GB + goff;
    u32x4 awv[8], swv[8];
#define DA_GLOAD() do { _Pragma("unroll") for (int i = 0; i < 8; ++i) { awv[i] = *(const u32x4*)(Ga + (size_t)i * 2 * PITCH); swv[i] = *(const u32x4*)(Gb + (size_t)i * 2 * PITCH); } } while (0)
    asm volatile("s_waitcnt lgkmcnt(0)\n\ts_barrier" ::: "memory");
    DA_LAS float* Xg = (DA_LAS float*)lds + g * 8192 + lane;
    if (mp == 1 && my_nt > 0) {
#pragma unroll
        for (int qb = 0; qb < 2; ++qb)
#pragma unroll
            for (int cb = 0; cb < 16; ++cb)
#pragma unroll
                for (int r = 0; r < 4; ++r) Xg[((qb * 16 + cb) * 4 + r) * 64] = o[qb][cb][r] * rli[qb][r];
        DA_GLOAD();
    }
    asm volatile("s_waitcnt lgkmcnt(0)\n\ts_barrier" ::: "memory");
    if (mp == 0 && my_nt > 0) {
#pragma unroll
        for (int qb = 0; qb < 2; ++qb)
#pragma unroll
            for (int cb = 0; cb < 16; ++cb)
#pragma unroll
                for (int r = 0; r < 4; ++r) o[qb][cb][r] = o[qb][cb][r] * rli[qb][r] - Xg[((qb * 16 + cb) * 4 + r) * 64];
        asm volatile("s_waitcnt lgkmcnt(0)" ::: "memory");
        DA_LAS bf16_t* stg = (DA_LAS bf16_t*)(lds + g * 32768);
        DA_LAS bf16_t* sw = stg + (4 * g4) * 264 + c16;
#pragma unroll
        for (int qb = 0; qb < 2; ++qb)
#pragma unroll
            for (int cb = 0; cb < 16; ++cb)
#pragma unroll
                for (int r = 0; r < 4; ++r) sw[(16 * qb + r) * 264 + cb * 16] = (bf16_t)(pg8::cvt_pk_bf16(o[qb][cb][r], o[qb][cb][r]) & 0xffffu);
        DA_GLOAD();
    }
    asm volatile("s_waitcnt lgkmcnt(0)\n\ts_barrier" ::: "memory");
    if (my_nt > 0) {
        const DA_LAS bf16_t* stg = (const DA_LAS bf16_t*)(lds + g * 32768);
        float sub[8];
        const pg8::f32x4 sub0 = *(const pg8::f32x4*)(subln + (lane & 31) * 8), sub1 = *(const pg8::f32x4*)(subln + (lane & 31) * 8 + 4);
        sub[0] = sub0[0]; sub[1] = sub0[1]; sub[2] = sub0[2]; sub[3] = sub0[3]; sub[4] = sub1[0]; sub[5] = sub1[1]; sub[6] = sub1[2]; sub[7] = sub1[3];
        const DA_LAS unsigned char* sr = (const DA_LAS unsigned char*)stg + (16 * mp + (lane >> 5)) * 528 + (lane & 31) * 16;
#pragma unroll
        for (int i = 0; i < 8; ++i) { const u32x4 w = *(const DA_LAS u32x4*)(sr + i * 2 * 528);
            const u32x4 aw = awv[i], sw_ = swv[i];
            float f[8], a[8], sg[8];
            f[0] = pg8::bf_lo(w.x); f[1] = pg8::bf_hi(w.x); f[2] = pg8::bf_lo(w.y); f[3] = pg8::bf_hi(w.y); f[4] = pg8::bf_lo(w.z); f[5] = pg8::bf_hi(w.z); f[6] = pg8::bf_lo(w.w); f[7] = pg8::bf_hi(w.w);
            a[0] = pg8::bf_lo(aw.x); a[1] = pg8::bf_hi(aw.x); a[2] = pg8::bf_lo(aw.y); a[3] = pg8::bf_hi(aw.y); a[4] = pg8::bf_lo(aw.z); a[5] = pg8::bf_hi(aw.z); a[6] = pg8::bf_lo(aw.w); a[7] = pg8::bf_hi(aw.w);
            sg[0] = pg8::bf_lo(sw_.x); sg[1] = pg8::bf_hi(sw_.x); sg[2] = pg8::bf_lo(sw_.y); sg[3] = pg8::bf_hi(sw_.y); sg[4] = pg8::bf_lo(sw_.z); sg[5] = pg8::bf_hi(sw_.z); sg[6] = pg8::bf_lo(sw_.w); sg[7] = pg8::bf_hi(sw_.w);
            float ss = 0.f;
#pragma unroll
            for (int e = 0; e < 8; ++e) ss += f[e] * f[e];
            ss += __shfl_xor(ss, 1); ss += __shfl_xor(ss, 2); ss += __shfl_xor(ss, 4); ss += __shfl_xor(ss, 8); ss += __shfl_xor(ss, 16);
            const float rs = __builtin_amdgcn_rsqf(ss * (1.f / 256.f) + 1e-6f) * 0.8f;
#pragma unroll
            for (int e = 0; e < 8; ++e) a[e] = a[e] + sg[e] * (f[e] * rs * sub[e]);
            u32x4 ow; ow.x = pg8::cvt_pk_bf16(a[0], a[1]); ow.y = pg8::cvt_pk_bf16(a[2], a[3]); ow.z = pg8::cvt_pk_bf16(a[4], a[5]); ow.w = pg8::cvt_pk_bf16(a[6], a[7]);
            *(u32x4*)(Ga + (size_t)i * 2 * PITCH) = ow; }
    }
    asm volatile("s_waitcnt lgkmcnt(0)\n\ts_barrier" ::: "memory");
#undef DA_GLOAD
#undef DA_W
#undef DA_MF
}
}

constexpr int NWAVES = 8;
#ifndef MK_N_LAUNCHES
#define MK_N_LAUNCHES 1
#endif
constexpr int N_LAUNCHES = MK_N_LAUNCHES;
constexpr int P1_CONV_WGS = 7, P5_CONV_WGS = 48;
constexpr int P7_SPLITS = 8;
constexpr int P7_WGM = 4;
constexpr int P1_WGM = 4;
constexpr int N_PHASES = 8;
static_assert(N_LAUNCHES == 1, "this build is the one-launch kernel (the split-K reduce after P7 needs the in-kernel grid barrier)");

constexpr int DM = 4096, SEQ = 8192, MP = 2 * SEQ, DEC_B = 8, DEC_T = 32, MS = DEC_B * DEC_T, M = MP + MS, PAST = 1024, SKROWS = 1088;
constexpr int POOL_IN = 2048, PG_IN = 512, PG_OUT = 1024, DFF = 11008, IN_COLS = 22528;
constexpr float EPS = 1e-6f;
constexpr float QSCALE = 0.08838834764831845f * 1.4426950408889634f;
constexpr float MBOUND = 11.313708498984761f * 1.4426950408889634f;
constexpr size_t OFF_Y = 0, OFF_NPP = 68157440, OFF_NKP = 68218880, OFF_NVP = 135327744, OFF_NPS = 202436608, OFF_NKS = 202682368, OFF_NVS = 203730944, OUT_SIZE = 204779520;

constexpr size_t MiB = 1u << 20;
constexpr size_t WS_CTL = 0, CTL_ZERO_BYTES = 1 * MiB;
constexpr size_t WS_WIN = 2 * MiB;
constexpr size_t WS_H = 178 * MiB;
constexpr size_t WS_SK = 308 * MiB, WS_SV = 376 * MiB;
constexpr size_t WS_WPOOL = 444 * MiB;
constexpr size_t WS_WOUT = 448 * MiB;
constexpr size_t WS_WFO = 480 * MiB;
constexpr size_t WS_POOLED = 566 * MiB;
constexpr size_t WS_U = 631 * MiB;
constexpr size_t WS_Q = 696 * MiB, WS_K = 826 * MiB, WS_V = 956 * MiB, WS_GA = 1086 * MiB, WS_GB = 1216 * MiB;
constexpr size_t WS_HFF = WS_Q;
constexpr size_t WS_PART = 1346 * MiB;
constexpr size_t WS_END = 1378 * MiB;
static_assert(WS_HFF + (size_t)M * DFF * 2 <= WS_GA, "Hff overlay");
constexpr int CW_TMO = 0, CW_CODE = 1;
constexpr int CW_BAR = 4096;
constexpr int CW_ROWSS = 16384;
static_assert((CW_ROWSS + M) * 4 <= (int)CTL_ZERO_BYTES, "CTL words inside the memset region");

constexpr int RING_OFF = 0, RING_BYTES = 131072;
constexpr int ATT_SCR_OFF = RING_BYTES;
constexpr int XS_OFF = RING_BYTES + 2048;
constexpr int LDSCTL_OFF = XS_OFF + 8192, MISC_OFF = LDSCTL_OFF + 320;
constexpr int LDS_BYTES = 147456;
static_assert(MISC_OFF + 128 <= LDS_BYTES && da::LDS_NEED <= LDSCTL_OFF, "LDS map");

#define GAS __attribute__((address_space(1)))
#define LAS __attribute__((address_space(3)))
typedef unsigned short bf16;
typedef unsigned v4u __attribute__((ext_vector_type(4)));
typedef float f32x4 __attribute__((ext_vector_type(4)));
typedef short bf16x8 __attribute__((ext_vector_type(8)));
typedef GAS unsigned gu32;
typedef GAS unsigned long long gu64;
#define RLX_AGENT __ATOMIC_RELAXED, __HIP_MEMORY_SCOPE_AGENT
#define LDS_WAIT() asm volatile("s_waitcnt lgkmcnt(0)" ::: "memory")
#define VM_WAIT() asm volatile("s_waitcnt vmcnt(0)" ::: "memory")
__device__ __forceinline__ unsigned long long rt() { return __builtin_amdgcn_s_memrealtime(); }
__device__ __forceinline__ unsigned f2bf(float f) { unsigned u = __builtin_bit_cast(unsigned, f); return (u + 0x7fffu + ((u >> 16) & 1u)) >> 16; }
__device__ __forceinline__ unsigned pk2(float lo, float hi) { return f2bf(lo) | (f2bf(hi) << 16); }

#define XB_TMO      128
#define XB_XCNT(j)  (256  + 64 * (j))
#define XB_XSUB(j)  (1280 + 64 * (j))
#define XB_XGEN(j)  (2304 + 64 * (j))
#define XB_TOP      3328
#define XB_TOPGEN   3392
#define XCD_BAR_WORDS 3456
#define XB_SPIN_CAP (1u << 18)

__device__ __forceinline__ unsigned xb_ld(unsigned* p)              { return __hip_atomic_load(p, __ATOMIC_RELAXED, __HIP_MEMORY_SCOPE_AGENT); }
__device__ __forceinline__ unsigned xb_add(unsigned* p, unsigned v) { return __hip_atomic_fetch_add(p, v, __ATOMIC_RELAXED, __HIP_MEMORY_SCOPE_AGENT); }
__device__ __forceinline__ unsigned xb_xcc_id() { return (unsigned)__builtin_amdgcn_s_getreg((3 << 11) | 20) & 0xFu; }
#define XB_SPIN(cond, bar) do { unsigned _sp = 0; while (cond) { __builtin_amdgcn_s_sleep(1); \
    if ((++_sp & 255u) == 0u) { if (xb_ld(&(bar)[XB_TMO])) break; if (_sp > XB_SPIN_CAP) { atomicAdd(&(bar)[XB_TMO], 1u); break; } } } } while (0)

struct XcdBarrier {
    unsigned* bar; unsigned x;
    volatile LAS unsigned* st;
};

__device__ __forceinline__ XcdBarrier xcd_barrier_post(unsigned* bar, volatile LAS unsigned* st) {
    XcdBarrier b; b.bar = bar; b.x = xb_xcc_id(); b.st = st;
    if (threadIdx.x == 0) (void)xb_add(&bar[XB_XCNT(b.x)], 1u);
    return b;
}
__device__ __forceinline__ void xcd_barrier_complete(unsigned* bar, unsigned x, unsigned& nloc, unsigned& nx) {
    const unsigned G = gridDim.x * gridDim.y * gridDim.z;
    unsigned sum, cnt, mine, sp = 0u;
    for (;;) {
        sum = 0u; cnt = 0u; mine = 0u;
#pragma unroll
        for (unsigned j = 0; j < 16; ++j) { const unsigned c = xb_ld(&bar[XB_XCNT(j)]); sum += c; cnt += (c > 0u) ? 1u : 0u; mine = (j == x) ? c : mine; }
        if (sum == G) break;
        __builtin_amdgcn_s_sleep(1);
        if ((++sp & 255u) == 0u) { if (xb_ld(&bar[XB_TMO])) break; if (sp > XB_SPIN_CAP) { atomicAdd(&bar[XB_TMO], 1u); break; } }
    }
    nloc = mine > 0u ? mine : 1u; nx = cnt > 0u ? cnt : 1u;
}

__device__ __forceinline__ void xcd_barrier(const XcdBarrier& b) {
    asm volatile("s_waitcnt vmcnt(0)" ::: "memory");
    __syncthreads();
    if (threadIdx.x == 0) {
        unsigned* bar = b.bar;
        __builtin_amdgcn_s_waitcnt(0);
        unsigned nloc = b.st[0], nx = b.st[1];
        if (nloc == 0u) { xcd_barrier_complete(bar, b.x, nloc, nx); b.st[0] = nloc; b.st[1] = nx; }
        const unsigned old = xb_add(&bar[XB_XSUB(b.x)], 1u);
        const unsigned gen = old / nloc;
        if (old + 1u == (gen + 1u) * nloc) {
            __builtin_amdgcn_fence(__ATOMIC_RELEASE, "agent");
            asm volatile("s_waitcnt vmcnt(0)" ::: "memory");
            const unsigned og = xb_add(&bar[XB_TOP], 1u);
            const unsigned tg = og / nx;
            if (og + 1u == (tg + 1u) * nx) xb_add(&bar[XB_TOPGEN], 1u);
            else XB_SPIN(xb_ld(&bar[XB_TOPGEN]) == tg, bar);
            __builtin_amdgcn_fence(__ATOMIC_ACQUIRE, "agent");
            xb_add(&bar[XB_XGEN(b.x)], 1u);
            asm volatile("s_waitcnt vmcnt(0)" ::: "memory");
        } else {
            XB_SPIN(xb_ld(&bar[XB_XGEN(b.x)]) == gen, bar);
            __builtin_amdgcn_fence(__ATOMIC_ACQUIRE, "agent");
            asm volatile("s_waitcnt vmcnt(0)" ::: "memory");
        }
    }
    __syncthreads();
}

struct Frame {
    LAS unsigned char* lds;
    volatile LAS unsigned* MISC;
    gu32* ctl;
    int tid, lane, wave;
    int vcu, G;
    const float* in[20]; float* out; unsigned char* ws;
};
enum { I_XP = 0, I_XS, I_CPOOL, I_CK, I_CV, I_NMIX, I_WIN, I_WPOOL, I_PSCALE, I_QN, I_KN, I_LQ1, I_LK1, I_LQ2, I_LK2, I_SUBLN, I_WOUT, I_NFFN, I_WFI, I_WFO };

__device__ __forceinline__ float wave_sum(float v) {
#pragma unroll
    for (int o = 1; o < 64; o <<= 1) v += __shfl_xor(v, o);
    return v;
}
__device__ __forceinline__ float wave_max(float v) {
#pragma unroll
    for (int o = 1; o < 64; o <<= 1) v = fmaxf(v, __shfl_xor(v, o));
    return v;
}
__device__ __forceinline__ void unpack8(const v4u w, float (&f)[8]) {
    f[0] = pg8::bf_lo(w.x); f[1] = pg8::bf_hi(w.x); f[2] = pg8::bf_lo(w.y); f[3] = pg8::bf_hi(w.y);
    f[4] = pg8::bf_lo(w.z); f[5] = pg8::bf_hi(w.z); f[6] = pg8::bf_lo(w.w); f[7] = pg8::bf_hi(w.w);
}
__device__ __forceinline__ v4u pack8f(const float (&f)[8]) {
    v4u o; o.x = pg8::cvt_pk_bf16(f[0], f[1]); o.y = pg8::cvt_pk_bf16(f[2], f[3]); o.z = pg8::cvt_pk_bf16(f[4], f[5]); o.w = pg8::cvt_pk_bf16(f[6], f[7]); return o;
}

__device__ __forceinline__ void transpose_load(const float* W, int N, int k0, int n0, int lane, f32x4 (&v)[8]) {
    const GAS float* p = (const GAS float*)W + (size_t)(k0 + 8 * (lane & 7)) * N + n0 + 4 * (lane >> 3);
#pragma unroll
    for (int e = 0; e < 8; ++e) v[e] = *(const GAS f32x4*)(p + (size_t)e * N);
}
__device__ __forceinline__ void transpose_store(bf16* WT, int Kd, size_t dst_row0, int k0, int lane, const f32x4 (&v)[8]) {
    GAS bf16* q = (GAS bf16*)WT + (dst_row0 + 4 * (lane >> 3)) * Kd + k0 + 8 * (lane & 7);
#pragma unroll
    for (int i = 0; i < 4; ++i) { v4u o; o.x = pg8::cvt_pk_bf16(v[0][i], v[1][i]); o.y = pg8::cvt_pk_bf16(v[2][i], v[3][i]); o.z = pg8::cvt_pk_bf16(v[4][i], v[5][i]); o.w = pg8::cvt_pk_bf16(v[6][i], v[7][i]);
        *(GAS v4u*)(q + (size_t)i * Kd) = o; }
}
__device__ __forceinline__ void transpose_item(const float* W, int N, bf16* WT, int Kd, size_t dst_row0, int k0, int n0, LAS float* scr, int lane) {
    (void)scr; f32x4 v[8]; transpose_load(W, N, k0, n0, lane, v); transpose_store(WT, Kd, dst_row0, k0, lane, v);
}

template <int MODE> __device__ __forceinline__ size_t transpose_drow(int n0) {
    if (MODE == 0) return (size_t)n0;
    const int up = n0 >= DFF, nn = up ? n0 - DFF : n0; return (size_t)256 * (nn / 128) + (up ? 128 : 0) + (nn % 128);
}
template <int MODE> __device__ __forceinline__ void transpose_range(const float* W, int N, bf16* WT, int Kd, int NB, int NIT, int w, int nw, int lane) {
    for (int it = w; it < NIT; it += 2 * nw) {
        const int it2 = it + nw; const bool has2 = it2 < NIT;
        const int kb = it / NB, nb = it % NB, kb2 = has2 ? it2 / NB : kb, nb2 = has2 ? it2 % NB : nb;
        f32x4 va[8], vb[8];
        transpose_load(W, N, kb * 64, nb * 32, lane, va);
        if (has2) transpose_load(W, N, kb2 * 64, nb2 * 32, lane, vb);
        transpose_store(WT, Kd, transpose_drow<MODE>(nb * 32), kb * 64, lane, va);
        if (has2) transpose_store(WT, Kd, transpose_drow<MODE>(nb2 * 32), kb2 * 64, lane, vb);
    }
}

__device__ __forceinline__ void rms_row_to_bf16(const float* xrow, const float* g, bf16* orow, int lane) {
    const GAS f32x4* xr = (const GAS f32x4*)xrow + lane; const GAS f32x4* gr = (const GAS f32x4*)g + lane;
    f32x4 v[16]; float s = 0.f;
#pragma unroll
    for (int j = 0; j < 16; ++j) { v[j] = xr[64 * j]; s += (v[j].x * v[j].x + v[j].y * v[j].y) + (v[j].z * v[j].z + v[j].w * v[j].w); }
    const float rs = __builtin_amdgcn_rsqf(wave_sum(s) * (1.f / DM) + EPS);
    GAS unsigned long long* o8 = (GAS unsigned long long*)orow + lane;
#pragma unroll
    for (int j = 0; j < 16; ++j) { const f32x4 gg = gr[64 * j];
        o8[64 * j] = (unsigned long long)pg8::cvt_pk_bf16(v[j].x * rs * gg.x, v[j].y * rs * gg.y) | ((unsigned long long)pg8::cvt_pk_bf16(v[j].z * rs * gg.z, v[j].w * rs * gg.w) << 32); }
}

__device__ __forceinline__ void p0_prologue(Frame& F) {
    LAS float* scr = (LAS float*)(F.lds + RING_OFF + F.wave * 16384);
    const int gw = F.vcu * NWAVES + F.wave, NGW = F.G * NWAVES;
    unsigned char* ws = F.ws;
    constexpr int NB_IN = IN_COLS / 32, I_IN = (DM / 64) * NB_IN;
    constexpr int NB_P = PG_OUT / 32, I_P1 = (PG_IN / 64) * NB_P, I_P = 4 * I_P1;
    transpose_range<0>(F.in[I_WIN], IN_COLS, (bf16*)(ws + WS_WIN), DM, NB_IN, I_IN, gw, NGW, F.lane);
    { constexpr int NB_O = DM / 32, I_O = (DM / 64) * NB_O;
      transpose_range<0>(F.in[I_WOUT], DM, (bf16*)(ws + WS_WOUT), DM, NB_O, I_O, gw, NGW, F.lane); }
    { constexpr int NB_O = DM / 32, I_FO = (DFF / 64) * NB_O;
      transpose_range<0>(F.in[I_WFO], DM, (bf16*)(ws + WS_WFO), DFF, NB_O, I_FO, gw, NGW, F.lane); }
    for (int r = gw; r < I_P; r += NGW) { const int gI = r / I_P1, q = r % I_P1, kb = q / NB_P, nb = q % NB_P;
        transpose_item(F.in[I_WPOOL] + (size_t)gI * PG_IN * PG_OUT, PG_OUT, (bf16*)(ws + WS_WPOOL) + (size_t)gI * PG_OUT * PG_IN, PG_IN, (size_t)nb * 32, kb * 64, nb * 32, scr, F.lane); }
    for (int m = gw; m < M; m += NGW) {
        const float* xrow = (m < MP) ? F.in[I_XP] + (size_t)m * DM : F.in[I_XS] + (size_t)(m - MP) * DM;
        rms_row_to_bf16(xrow, F.in[I_NMIX], (bf16*)(ws + WS_H) + (size_t)m * DM, F.lane);
    }
}
__device__ __forceinline__ void conv_p1(Frame& F, int w, int nw) {
    LAS float* scr = (LAS float*)(F.lds + RING_OFF + F.wave * 16384);
    unsigned char* ws = F.ws;
    constexpr int CROWS = DEC_B * PAST;
    for (int r = w; r < 2 * CROWS + 2 * DEC_B * 32; r += nw) {
        if (r < 2 * CROWS) { const int isv = r >= CROWS, rr = isv ? r - CROWS : r, b = rr / PAST, s = rr % PAST;
            const GAS f32x4* src = (const GAS f32x4*)((isv ? F.in[I_CV] : F.in[I_CK]) + (size_t)rr * DM);
            GAS v4u* dst = (GAS v4u*)((bf16*)(ws + (isv ? WS_SV : WS_SK)) + (size_t)(b * SKROWS + s) * DM);
#pragma unroll
            for (int j = 0; j < 8; ++j) { const int ch = j * 64 + F.lane; const f32x4 a = src[2 * ch], c = src[2 * ch + 1];
                v4u o; o.x = pg8::cvt_pk_bf16(a.x, a.y); o.y = pg8::cvt_pk_bf16(a.z, a.w); o.z = pg8::cvt_pk_bf16(c.x, c.y); o.w = pg8::cvt_pk_bf16(c.z, c.w); dst[ch] = o; }
        } else { const int q = r - 2 * CROWS, isv = q >= DEC_B * 32, qq = isv ? q - DEC_B * 32 : q, b = qq / 32, s = PAST + DEC_T + qq % 32;
            GAS v4u* dst = (GAS v4u*)((bf16*)(ws + (isv ? WS_SV : WS_SK)) + (size_t)(b * SKROWS + s) * DM);
#pragma unroll
            for (int j = 0; j < 8; ++j) dst[j * 64 + F.lane] = (v4u){0u, 0u, 0u, 0u}; }
    }
}
__device__ __forceinline__ void conv_p5(Frame& F, int w, int nw) {
    LAS float* scr = (LAS float*)(F.lds + RING_OFF + F.wave * 16384);
    constexpr int NB = (2 * DFF) / 32, NIT = (DM / 64) * NB;
    transpose_range<1>(F.in[I_WFI], 2 * DFF, (bf16*)(F.ws + WS_WIN), DM, NB, NIT, w, nw, F.lane);
}

template <int G_> __device__ __forceinline__ void p2_pool_batch(Frame& F, int row0, bool samp, int b, int t0) {
    constexpr int W = 2 << G_, NB = 8, NR = NB + W - 1;
    unsigned char* ws = F.ws; const int lane = F.lane; const int c0 = G_ * PG_IN + lane * 8;
    const bf16* U = (const bf16*)(ws + WS_U);
    v4u rw[NR];
#pragma unroll
    for (int a = 0; a < NR; ++a) { const int tt = t0 - (W - 1) + a;
        if (tt >= 0) rw[a] = *(const GAS v4u*)(U + (size_t)(row0 - (W - 1) + a) * POOL_IN + c0);
        else if (samp) { const GAS f32x4* cp = (const GAS f32x4*)(F.in[I_CPOOL] + ((size_t)b * 15 + (15 + tt)) * POOL_IN + c0); const f32x4 x0 = cp[0], x1 = cp[1];
            v4u o; o.x = pg8::cvt_pk_bf16(x0.x, x0.y); o.y = pg8::cvt_pk_bf16(x0.z, x0.w); o.z = pg8::cvt_pk_bf16(x1.x, x1.y); o.w = pg8::cvt_pk_bf16(x1.z, x1.w); rw[a] = o; }
        else rw[a] = (v4u){0u, 0u, 0u, 0u}; }
    float S[8];
#pragma unroll
    for (int e = 0; e < 8; ++e) S[e] = 0.f;
#pragma unroll
    for (int a = 0; a < W; ++a) { float f[8]; unpack8(rw[a], f);
#pragma unroll
        for (int e = 0; e < 8; ++e) S[e] += f[e]; }
#pragma unroll
    for (int i = 0; i < NB; ++i) { const int t = t0 + i, row = row0 + i;
        float cur[8]; unpack8(rw[i + W - 1], cur);
        const int cnt = samp ? W : ((t + 1 < W) ? t + 1 : W);
        const float inv = 1.0f / (float)cnt;
        float p[8];
#pragma unroll
        for (int e = 0; e < 8; ++e) p[e] = S[e] * inv - cur[e];
        *(GAS v4u*)((bf16*)(ws + WS_POOLED) + ((size_t)G_ * M + row) * PG_IN + lane * 8) = pack8f(p);
        float* np = nullptr;
        if (!samp && t >= SEQ - 15) np = F.out + OFF_NPP + ((size_t)b * 15 + (t - (SEQ - 15))) * POOL_IN + c0;
        if (samp && t >= DEC_T - 15) np = F.out + OFF_NPS + ((size_t)b * 15 + (t - (DEC_T - 15))) * POOL_IN + c0;
        if (np) { *(GAS f32x4*)np = (f32x4){cur[0], cur[1], cur[2], cur[3]}; *(GAS f32x4*)(np + 4) = (f32x4){cur[4], cur[5], cur[6], cur[7]}; }
        if (i < NB - 1) { float fn[8], fo[8]; unpack8(rw[i + W], fn); unpack8(rw[i], fo);
#pragma unroll
            for (int e = 0; e < 8; ++e) S[e] += fn[e] - fo[e]; } }
}
__device__ __forceinline__ void pool_quad(Frame& F, int quad) {
    const int pm = quad >> 2, gI = quad & 3;
    for (int j = F.wave; j < 32; j += NWAVES) { const int row0 = pm * 256 + 8 * j; const bool samp = row0 >= MP;
        const int b = samp ? (row0 - MP) / DEC_T : row0 / SEQ, t0 = samp ? (row0 - MP) % DEC_T : row0 % SEQ;
        if (gI == 0) p2_pool_batch<0>(F, row0, samp, b, t0); else if (gI == 1) p2_pool_batch<1>(F, row0, samp, b, t0);
        else if (gI == 2) p2_pool_batch<2>(F, row0, samp, b, t0); else p2_pool_batch<3>(F, row0, samp, b, t0); }
}

__device__ __forceinline__ void p4_attention(Frame& F) {
    unsigned char* ws = F.ws;
    float lam, Mshift;
    { const int l2 = F.lane * 2;
      const float s1 = wave_sum(F.in[I_LQ1][l2] * F.in[I_LK1][l2] + F.in[I_LQ1][l2 + 1] * F.in[I_LK1][l2 + 1]);
      const float s2 = wave_sum(F.in[I_LQ2][l2] * F.in[I_LK2][l2] + F.in[I_LQ2][l2 + 1] * F.in[I_LK2][l2 + 1]);
      lam = __expf(s1) - __expf(s2) + 0.2f;
      const float gq = wave_max(fmaxf(fabsf(F.in[I_QN][l2]), fabsf(F.in[I_QN][l2 + 1]))), gk = wave_max(fmaxf(fabsf(F.in[I_KN][l2]), fabsf(F.in[I_KN][l2 + 1])));
      Mshift = MBOUND * gq * gk;
      lam = __uint_as_float(__builtin_amdgcn_readfirstlane(__float_as_uint(lam))); Mshift = __uint_as_float(__builtin_amdgcn_readfirstlane(__float_as_uint(Mshift))); }
    const bf16* Qb = (const bf16*)(ws + WS_Q); const bf16* Kb = (const bf16*)(ws + WS_K); const bf16* Vb = (const bf16*)(ws + WS_V);
    const bf16* SKb = (const bf16*)(ws + WS_SK); const bf16* SVb = (const bf16*)(ws + WS_SV);
    bf16* GAb = (bf16*)(ws + WS_GA); const bf16* GBb = (const bf16*)(ws + WS_GB);
    for (int v = F.vcu; v < 256; v += F.G) {
        const int xcd = v >> 5, j = v & 31;
        for (int idx = 0; idx < 9; ++idx) {
            da::Unit u;
            if (idx < 8) { const int bh = xcd * 4 + (idx >> 1), b = bh >> 4, h = bh & 15, k2 = 2 * (j >> 1), uq = (j & 1) ? ((idx & 1) ? k2 + 1 : 63 - k2) : ((idx & 1) ? k2 : 62 - k2);
                u.Q = Qb + ((size_t)b * SEQ + (size_t)uq * 128) * DM + h * 256; u.O = (bf16*)u.Q; u.GA = GAb + (u.Q - Qb); u.GB = GBb + (u.Q - Qb);
                u.K = Kb + (size_t)b * SEQ * DM + h * 256; u.V = Vb + (size_t)b * SEQ * DM + h * 256;
                u.nt = 2 * uq + 2; u.nt_lo = 2 * uq + 1; u.nt_hi = 2 * uq + 2; u.sample = 0; }
            else { if (v & 1) break; const int si = v >> 1, b = si >> 4, h = si & 15;
                u.Q = Qb + ((size_t)MP + (size_t)b * DEC_T) * DM + h * 256; u.O = (bf16*)u.Q; u.GA = GAb + (u.Q - Qb); u.GB = GBb + (u.Q - Qb);
                u.K = SKb + (size_t)b * SKROWS * DM + h * 256; u.V = SVb + (size_t)b * SKROWS * DM + h * 256;
                u.nt = 17; u.nt_lo = 17; u.nt_hi = 17; u.sample = 1; }
            da::attn_unit(u, F.lds + RING_OFF, lam, Mshift, F.in[I_SUBLN]);
        }
    }
}

struct Args { const float* in[20]; float* out; unsigned char* ws; int ph_lo, ph_hi, li, pad; };
__global__ void __launch_bounds__(NWAVES * 64, 2) mk_fwd(Args args) {
    extern __shared__ __attribute__((aligned(16))) unsigned char lds[];
    Frame F;
    F.lds = (LAS unsigned char*)lds;
    F.MISC = (volatile LAS unsigned*)(F.lds + MISC_OFF);
    F.tid = threadIdx.x; F.lane = F.tid & 63; F.wave = __builtin_amdgcn_readfirstlane(F.tid >> 6);
    F.G = gridDim.x; { const int bx = blockIdx.x; F.vcu = (F.G % 8 == 0) ? (bx % 8) * (F.G / 8) + bx / 8 : bx; }
#pragma unroll
    for (int i = 0; i < 20; ++i) F.in[i] = args.in[i];
    F.out = args.out; F.ws = args.ws;
    unsigned char* ws = args.ws;
    F.ctl = (gu32*)(ws + WS_CTL);
    for (int u = F.tid; u < (LDS_BYTES - LDSCTL_OFF) / 4; u += NWAVES * 64) ((LAS unsigned*)(F.lds + LDSCTL_OFF))[u] = 0u;
    __syncthreads();
    XcdBarrier bar; bar.bar = (unsigned*)(F.ctl + CW_BAR); bar.x = 0; bar.st = nullptr;
    if (N_LAUNCHES == 1) bar = xcd_barrier_post((unsigned*)(F.ctl + CW_BAR), F.MISC + 8);
#define GRID_BAR(seam) do { if (N_LAUNCHES != 1) { if (F.tid == 0) __hip_atomic_store(F.ctl + CW_TMO, 0xBADBA0u | (unsigned)(seam), RLX_AGENT); } else { xcd_barrier(bar); } } while (0)
    const int lo = args.ph_lo, hi = args.ph_hi;
#ifndef PH_MASK
#define PH_MASK 0xff
#endif
#define IN(k) (((PH_MASK >> (k)) & 1) && lo <= (k) && (k) < hi)
#define BOTH(k) (IN(k) && IN((k) + 1))
    bf16* const Wt_in = (bf16*)(ws + WS_WIN); bf16* const Hb = (bf16*)(ws + WS_H);
    float* const rowss = (float*)(ws + WS_CTL) + CW_ROWSS;

    if (IN(0)) {
        p0_prologue(F); if (BOTH(0)) GRID_BAR(0); }

    if (IN(1)) {
        const int nabs = pg8::AbsOrder::fit((M / 256) * (IN_COLS / 256), F.G, P1_CONV_WGS);
        if (nabs == 0) { conv_p1(F, F.vcu * NWAVES + F.wave, F.G * NWAVES); __syncthreads(); }
        else if ((int)blockIdx.x >= F.G - nabs) conv_p1(F, ((int)blockIdx.x - (F.G - nabs)) * NWAVES + F.wave, nabs * NWAVES);
        pg8::Gemm g{Hb, Wt_in, M, IN_COLS, DM, 0, 0}; pg8::AbsOrder S; S.init(M, IN_COLS, F.G, (int)blockIdx.x, nabs, P1_WGM);
        pg8::EpiInProj E{(bf16*)(ws + WS_U), (bf16*)(ws + WS_Q), (bf16*)(ws + WS_K), (bf16*)(ws + WS_V), (bf16*)(ws + WS_GA), (bf16*)(ws + WS_GB), (bf16*)(ws + WS_SK), (bf16*)(ws + WS_SV),
                            F.out + OFF_NVP, F.out + OFF_NVS, F.out + OFF_NKP, F.out + OFF_NKS, F.in[I_QN], F.in[I_KN], (LAS float*)(F.lds + XS_OFF), QSCALE};
        pg8::gemm_phase<pg8::EpiInProj, pg8::AbsOrder, true, true>(F.lds + RING_OFF, g, S, E);
        if (BOTH(1)) GRID_BAR(1);
    }

    if (IN(3)) {
        pg8::QuadOrder S; S.init(M, F.G, F.vcu);
        for (int j = 0; j < S.nown; ++j) pool_quad(F, S.c + j * S.G);
        if (S.has_left()) pool_quad(F, S.left_quad());
        asm volatile("s_waitcnt vmcnt(0)" ::: "memory"); __syncthreads();
        pg8::Gemm g{(bf16*)(ws + WS_POOLED), (bf16*)(ws + WS_WPOOL), M, 4 * PG_OUT, PG_IN, (size_t)M * PG_IN * 2, 4};
        pg8::EpiPool E{(bf16*)(ws + WS_GA), F.in[I_PSCALE]};
        pg8::gemm_phase<pg8::EpiPool, pg8::QuadOrder, true, true>(F.lds + RING_OFF, g, S, E);
        if (BOTH(3)) GRID_BAR(3);
    }

    if (IN(4)) { p4_attention(F); if (BOTH(4)) GRID_BAR(4); }

    if (IN(5)) {
        const int nabs = pg8::AbsOrder::fit((M / 256) * (DM / 256), F.G, P5_CONV_WGS);
        if (nabs == 0) { conv_p5(F, F.vcu * NWAVES + F.wave, F.G * NWAVES); __syncthreads(); }
        else if ((int)blockIdx.x >= F.G - nabs) conv_p5(F, ((int)blockIdx.x - (F.G - nabs)) * NWAVES + F.wave, nabs * NWAVES);
        pg8::Gemm g{(bf16*)(ws + WS_GA), (bf16*)(ws + WS_WOUT), M, DM, DM, 0, 0}; pg8::AbsOrder S; S.init(M, DM, F.G, (int)blockIdx.x, nabs, 4);
        pg8::EpiWout E{F.in[I_XP], F.in[I_XS], F.out + OFF_Y, Hb, F.in[I_NFFN], rowss};
        pg8::gemm_phase<pg8::EpiWout, pg8::AbsOrder, true, true>(F.lds + RING_OFF, g, S, E);
        if (BOTH(5)) GRID_BAR(5);
    }

    if (IN(6)) {
        pg8::Gemm g{Hb, Wt_in, M, 2 * DFF, DM, 0, 0}; pg8::StaticOrder S; S.init(M, 2 * DFF, F.G, (int)blockIdx.x, P1_WGM);
        pg8::EpiSwiGLU E{(bf16*)(ws + WS_HFF), rowss};
        pg8::gemm_phase<pg8::EpiSwiGLU, pg8::StaticOrder, true, true>(F.lds + RING_OFF, g, S, E);
        if (BOTH(6)) GRID_BAR(6);
    }

    if (IN(7)) {
        pg8::Gemm g{(bf16*)(ws + WS_HFF), (bf16*)(ws + WS_WFO), M, DM, DFF, 0, 0}; pg8::SplitOrder S; S.init(MP, DM, DFF, F.G, (int)blockIdx.x, P7_SPLITS, P7_WGM);
        pg8::EpiFfnOut E{F.out + OFF_Y, (float*)(ws + WS_PART)};
        pg8::gemm_phase<pg8::EpiFfnOut, pg8::SplitOrder, true, true>(F.lds + RING_OFF, g, S, E);
        if (IN(7) && N_LAUNCHES == 1) { GRID_BAR(7);
            const int gw = F.vcu * NWAVES + F.wave, NGW = F.G * NWAVES;
            for (int r = gw; r < MS; r += NGW) { GAS f32x4* yr = (GAS f32x4*)(F.out + OFF_Y + (size_t)(MP + r) * DM) + F.lane;
#pragma unroll 1
                for (int j = 0; j < 16; ++j) { f32x4 a = yr[64 * j];
#pragma unroll
                    for (int s = 0; s < P7_SPLITS; ++s) a += ((const GAS f32x4*)((const float*)(ws + WS_PART) + ((size_t)s * 256 + r) * DM) + F.lane)[64 * j];
                    yr[64 * j] = a; } } }
    }
#undef IN
#undef BOTH
#undef GRID_BAR
}

extern "C" void kernel_launch(void* const* d_in, const int* in_sizes, int n_in, void* d_out, int out_size, void* d_ws, size_t ws_size, hipStream_t stream) {
    static int grid = 0;
    if (grid == 0) {
        if (n_in != 20 || in_sizes[0] != MP * DM || (size_t)out_size != OUT_SIZE || ws_size < WS_END) {
            fprintf(stderr, "kernel_launch: shape mismatch: n_in %d in0 %d out %d ws %zu (need >= %zu); nothing launched\n", n_in, n_in > 0 ? in_sizes[0] : -1, out_size, ws_size, (size_t)WS_END); grid = -1; return; }
        int dev = 0, cus = 0, per_cu = 0;
        if (hipGetDevice(&dev) != hipSuccess || hipDeviceGetAttribute(&cus, hipDeviceAttributeMultiprocessorCount, dev) != hipSuccess) { fprintf(stderr, "kernel_launch: device query failed\n"); grid = -1; return; }
        if (hipFuncSetAttribute((const void*)mk_fwd, hipFuncAttributeMaxDynamicSharedMemorySize, LDS_BYTES) != hipSuccess) { fprintf(stderr, "kernel_launch: hipFuncSetAttribute failed\n"); grid = -1; return; }
        if (hipOccupancyMaxActiveBlocksPerMultiprocessor(&per_cu, (const void*)mk_fwd, NWAVES * 64, LDS_BYTES) != hipSuccess || per_cu < 1)
            fprintf(stderr, "kernel_launch: note: occupancy query reports %d workgroups per CU\n", per_cu);
        (void)hipGetLastError();
        grid = cus;
    }
    if (grid < 0) return;
    if (hipMemsetAsync((char*)d_ws + WS_CTL, 0, CTL_ZERO_BYTES, stream) != hipSuccess) { fprintf(stderr, "kernel_launch: hipMemsetAsync failed\n"); return; }
    Args a{};
    for (int i = 0; i < 20; ++i) a.in[i] = (const float*)d_in[i];
    a.out = (float*)d_out; a.ws = (unsigned char*)d_ws;
    for (int li = 0; li < N_LAUNCHES; ++li) {
        a.ph_lo = (N_LAUNCHES == 1) ? 0 : li; a.ph_hi = (N_LAUNCHES == 1) ? N_PHASES : li + 1; a.li = li; a.pad = 0;
        hipLaunchKernelGGL(mk_fwd, dim3(grid), dim3(NWAVES * 64), LDS_BYTES, stream, a);
        const hipError_t le = hipPeekAtLastError();
        if (le != hipSuccess) { fprintf(stderr, "kernel_launch: launch %d failed: %s\n", li, hipGetErrorName(le)); break; }
    }
}
```
